# Optimizing an MI355X kernel written in HIP

```python
import math
import jax, jax.numpy as jnp
from jax import lax
import numpy as np

D_MODEL = 2048
BATCH = 4
SEQ = 2048
DEPTH = 1
DEC_BATCH = 128
DEC_SEQ = 4
PAST_LEN = 16384
PAGE_SIZE = 128

SSM_WIDTH = D_MODEL // 2
SSM_HEADDIM = 64
SSM_HEADS = SSM_WIDTH // SSM_HEADDIM
SSM_GROUPS = 2
SSM_REP = SSM_HEADS // SSM_GROUPS
D_STATE = 128
CONV_WIDTH = 4
CONV_DIM = SSM_WIDTH + 2 * SSM_GROUPS * D_STATE
SSD_CHUNK = 128
ATT_WIDTH = D_MODEL - SSM_WIDTH
HEAD_DIM = 64
ATT_HEADS = ATT_WIDTH // HEAD_DIM
KV_HEADS = 2
KV_REP = ATT_HEADS // KV_HEADS
WINDOW = 128
ROT_DIM = HEAD_DIM // 4
ROPE_THETA = 500000.0
MIX_WIDTH = SSM_WIDTH + ATT_WIDTH
IN_DIM = SSM_WIDTH + CONV_DIM + SSM_HEADS + ATT_WIDTH + 2 * KV_HEADS * HEAD_DIM
N_MEM = 256
X_HEADS = 4
X_HEAD_DIM = 128
X_WIDTH = X_HEADS * X_HEAD_DIM
D_FF = -(-8 * D_MODEL // (3 * 256)) * 256
EPS = 1e-5

kernel_name = 'hymba_ssd_swa_memxattn_step'


def rmsnorm(x, w):
    xf = x.astype(jnp.float32)
    y = xf * lax.rsqrt(jnp.mean(xf * xf, axis=-1, keepdims=True) + EPS)
    return (y * w.astype(jnp.float32)).astype(x.dtype)


def rope(x, pos):
    half = ROT_DIM // 2
    inv = ROPE_THETA ** (-jnp.arange(half, dtype=jnp.float32) * (2.0 / ROT_DIM))
    ang = pos.astype(jnp.float32)[:, None] * inv[None, :]
    cos = jnp.cos(ang)[None, :, None, :]
    sin = jnp.sin(ang)[None, :, None, :]
    xr = x[..., :ROT_DIM].astype(jnp.float32)
    x1, x2 = xr[..., :half], xr[..., half:]
    rot = jnp.concatenate([x1 * cos - x2 * sin, x2 * cos + x1 * sin], axis=-1).astype(x.dtype)
    return jnp.concatenate([rot, x[..., ROT_DIM:]], axis=-1)


def causal_conv(xbc, buf, w, bias):
    T = xbc.shape[1]
    xp = jnp.concatenate([buf.astype(xbc.dtype), xbc], axis=1)
    out = bias
    for k in range(CONV_WIDTH):
        out = out + xp[:, k:k + T] * w[k]
    return jax.nn.silu(out), xp[:, -(CONV_WIDTH - 1):]


def ssd_scan(x, dt, a, bmat, cmat, h0):
    b, T, G, R, P = x.shape
    N = bmat.shape[-1]
    cl = SSD_CHUNK if T % SSD_CHUNK == 0 else T
    nc = T // cl
    f32 = jnp.float32
    xr = x.astype(f32).reshape(b, nc, cl, G, R, P)
    dtr = dt.astype(f32).reshape(b, nc, cl, G, R)
    br = bmat.astype(f32).reshape(b, nc, cl, G, N)
    cr = cmat.astype(f32).reshape(b, nc, cl, G, N)
    cs = jnp.cumsum(dtr * a.astype(f32), axis=2)
    causal = jnp.tril(jnp.ones((cl, cl), bool))[None, None, :, :, None, None]
    seg = cs[:, :, :, None] - cs[:, :, None, :]
    decay = jnp.exp(jnp.where(causal, seg, -jnp.inf))
    cb = jnp.einsum('bctgn,bcsgn->bctsg', cr, br)
    wts = cb[..., None] * decay * dtr[:, :, None]
    y_diag = jnp.einsum('bctsgr,bcsgrp->bctgrp', wts, xr)
    to_end = jnp.exp(cs[:, :, -1:] - cs) * dtr
    chunk_states = jnp.einsum('bclgn,bclgrp->bcgrpn', br, xr * to_end[..., None])
    chunk_decay = jnp.exp(cs[:, :, -1])

    def step(h, inp):
        st, dec = inp
        return h * dec[..., None, None] + st, h

    h_last, h_starts = lax.scan(step, h0.astype(f32),
                                (jnp.moveaxis(chunk_states, 1, 0), jnp.moveaxis(chunk_decay, 1, 0)))
    h_starts = jnp.moveaxis(h_starts, 0, 1)
    y_off = jnp.einsum('bclgn,bcgrpn->bclgrp', cr, h_starts) * jnp.exp(cs)[..., None]
    y = (y_diag + y_off).reshape(b, T, G, R, P)
    return y, h_last


def sink_softmax(s, mask, sink):
    s = jnp.where(mask, s, -jnp.inf)
    m = jnp.maximum(jnp.max(s, axis=-1, keepdims=True), sink)
    e = jnp.exp(s - m)
    return e / (jnp.sum(e, axis=-1, keepdims=True) + jnp.exp(sink - m))


def swa_banded(q, k, v, sinks):
    b, T = q.shape[0], q.shape[1]
    nb = T // WINDOW
    qb = q.reshape(b, nb, WINDOW, KV_HEADS, KV_REP, HEAD_DIM)
    pad = jnp.zeros((b, WINDOW, KV_HEADS, HEAD_DIM), k.dtype)
    kp = jnp.concatenate([pad, k], axis=1).reshape(b, nb + 1, WINDOW, KV_HEADS, HEAD_DIM)
    vp = jnp.concatenate([pad, v], axis=1).reshape(b, nb + 1, WINDOW, KV_HEADS, HEAD_DIM)
    kb = jnp.concatenate([kp[:, :-1], kp[:, 1:]], axis=2)
    vb = jnp.concatenate([vp[:, :-1], vp[:, 1:]], axis=2)
    s = jnp.einsum('bnqgrd,bnkgd->bngrqk', qb, kb).astype(jnp.float32) * HEAD_DIM ** -0.5
    qi = jnp.arange(WINDOW)[:, None]
    kj = jnp.arange(2 * WINDOW)[None, :]
    rel = qi + WINDOW - kj
    blk = jnp.arange(nb)[:, None, None]
    mask = (rel >= 0) & (rel < WINDOW) & (blk * WINDOW - WINDOW + kj >= 0)
    p = sink_softmax(s, mask[None, :, None, None], sinks)
    o = jnp.einsum('bngrqk,bnkgd->bnqgrd', p.astype(v.dtype), vb)
    return o.reshape(b, T, ATT_HEADS, HEAD_DIM)


def swa_cached(q, kcat, vcat, q_pos, k_pos, sinks):
    b, T = q.shape[0], q.shape[1]
    qg = q.reshape(b, T, KV_HEADS, KV_REP, HEAD_DIM)
    s = jnp.einsum('btgrd,bkgd->bgrtk', qg, kcat).astype(jnp.float32) * HEAD_DIM ** -0.5
    rel = q_pos[:, None] - k_pos[None, :]
    mask = (rel >= 0) & (rel < WINDOW)
    p = sink_softmax(s, mask, sinks)
    o = jnp.einsum('bgrtk,bkgd->btgrd', p.astype(vcat.dtype), vcat)
    return o.reshape(b, T, ATT_HEADS, HEAD_DIM)


def mixer(h, pos, ssm0, conv0, kbuf, vbuf, lp):
    b, T, _ = h.shape
    s1 = SSM_WIDTH
    s2 = s1 + CONV_DIM
    s3 = s2 + SSM_HEADS
    s4 = s3 + ATT_WIDTH
    s5 = s4 + KV_HEADS * HEAD_DIM
    proj = h @ lp['w_in']
    z, xbc, dt_raw, q, k, v = jnp.split(proj, [s1, s2, s3, s4, s5], axis=-1)
    xbc, conv_new = causal_conv(xbc, conv0, lp['conv_w'], lp['conv_b'])
    xs, bm, cm = jnp.split(xbc, [SSM_WIDTH, SSM_WIDTH + SSM_GROUPS * D_STATE], axis=-1)
    xs = xs.reshape(b, T, SSM_GROUPS, SSM_REP, SSM_HEADDIM)
    dt = jax.nn.softplus((dt_raw + lp['dt_bias']).astype(jnp.float32)).reshape(b, T, SSM_GROUPS, SSM_REP)
    a = -jnp.exp(lp['a_log'].astype(jnp.float32)).reshape(SSM_GROUPS, SSM_REP)
    y, ssm_new = ssd_scan(xs, dt, a,
                          bm.reshape(b, T, SSM_GROUPS, D_STATE), cm.reshape(b, T, SSM_GROUPS, D_STATE),
                          ssm0.reshape(b, SSM_GROUPS, SSM_REP, SSM_HEADDIM, D_STATE))
    y = y + xs.astype(jnp.float32) * lp['d_skip'].astype(jnp.float32).reshape(SSM_GROUPS, SSM_REP)[:, :, None]
    y = y.astype(h.dtype).reshape(b, T, SSM_WIDTH)
    g = (y * jax.nn.silu(z)).reshape(b, T, SSM_GROUPS, SSM_WIDTH // SSM_GROUPS)
    y = rmsnorm(g, lp['gate_norm'].reshape(SSM_GROUPS, -1)).reshape(b, T, SSM_WIDTH)
    q = rope(q.reshape(b, T, ATT_HEADS, HEAD_DIM), pos)
    k = rope(k.reshape(b, T, KV_HEADS, HEAD_DIM), pos)
    v = v.reshape(b, T, KV_HEADS, HEAD_DIM)
    sinks = lp['sinks'].astype(jnp.float32).reshape(KV_HEADS, KV_REP, 1, 1)
    if kbuf is None:
        att = swa_banded(q, k, v, sinks)
        k_new, v_new = k[:, -WINDOW:], v[:, -WINDOW:]
    else:
        nbuf = kbuf.shape[1]
        kcat = jnp.concatenate([kbuf.astype(k.dtype), k], axis=1)
        vcat = jnp.concatenate([vbuf.astype(v.dtype), v], axis=1)
        k_pos = pos[0] - nbuf + jnp.arange(nbuf + T)
        att = swa_cached(q, kcat, vcat, pos, k_pos, sinks)
        k_new, v_new = kcat[:, -nbuf:], vcat[:, -nbuf:]
    out = jnp.concatenate([y, att.reshape(b, T, ATT_WIDTH)], axis=-1) @ lp['w_out']
    ssm_new = ssm_new.reshape(b, SSM_HEADS, SSM_HEADDIM, D_STATE).astype(ssm0.dtype)
    return out, ssm_new, conv_new, k_new, v_new


def memory_kv(mem, lp):
    m = rmsnorm(mem, lp['norm_mem'])
    b, M, _ = m.shape
    mk = (m @ lp['w_xk']).reshape(b, M, X_HEADS, X_HEAD_DIM)
    mv = (m @ lp['w_xv']).reshape(b, M, X_HEADS, X_HEAD_DIM)
    return mk, mv


def cross_attn(h, mk, mv, lp):
    b, T, _ = h.shape
    q = (h @ lp['w_xq']).reshape(b, T, X_HEADS, X_HEAD_DIM)
    s = jnp.einsum('bthd,bmhd->bhtm', q, mk.astype(q.dtype)).astype(jnp.float32) * X_HEAD_DIM ** -0.5
    p = jax.nn.softmax(s, axis=-1).astype(h.dtype)
    o = jnp.einsum('bhtm,bmhd->bthd', p, mv.astype(h.dtype)).reshape(b, T, X_WIDTH)
    return o @ lp['w_xo']


def ffn(h, lp):
    return (jax.nn.silu(h @ lp['w_gate']) * (h @ lp['w_up'])) @ lp['w_down']


def layer(x, pos, ssm0, conv0, kbuf, vbuf, mk, mv, lp):
    mix, ssm_new, conv_new, k_new, v_new = mixer(rmsnorm(x, lp['norm_mix']), pos, ssm0, conv0, kbuf, vbuf, lp)
    x = x + mix
    x = x + cross_attn(rmsnorm(x, lp['norm_x']), mk, mv, lp)
    x = x + ffn(rmsnorm(x, lp['norm_ffn']), lp)
    return x, ssm_new, conv_new, k_new, v_new


def setup_inputs(seed: int = 0) -> dict:
    key = jax.random.key(seed)
    ks = jax.random.split(key, 30)
    L = DEPTH
    n_buf = min(WINDOW, PAST_LEN)

    def nrm(k, shape, scale):
        return jax.random.normal(k, shape, jnp.float32) * scale

    def gain(k, shape):
        return 1.0 + 0.05 * jax.random.normal(k, shape, jnp.float32)

    dt0 = jnp.exp(jax.random.uniform(ks[13], (L, SSM_HEADS), jnp.float32,
                                     minval=math.log(1e-3), maxval=math.log(1e-1)))
    dt_bias = dt0 + jnp.log(-jnp.expm1(-dt0))
    a_log = jnp.log(jax.random.uniform(ks[14], (L, SSM_HEADS), jnp.float32, minval=1.0, maxval=16.0))
    return {
        'x_prompt': nrm(ks[0], (BATCH, SEQ, D_MODEL), 1.0),
        'x_sample': nrm(ks[1], (DEC_BATCH, DEC_SEQ, D_MODEL), 1.0),
        'mem_prompt': nrm(ks[2], (BATCH, N_MEM, D_MODEL), 1.0),
        'state_ssm': nrm(ks[3], (L, DEC_BATCH, SSM_HEADS, SSM_HEADDIM, D_STATE), 0.5),
        'state_conv': nrm(ks[4], (L, DEC_BATCH, CONV_WIDTH - 1, CONV_DIM), 1.0),
        'cache_swa_k': nrm(ks[5], (L, DEC_BATCH, n_buf, KV_HEADS, HEAD_DIM), 1.0),
        'cache_swa_v': nrm(ks[6], (L, DEC_BATCH, n_buf, KV_HEADS, HEAD_DIM), 1.0),
        'cache_mem_k': nrm(ks[7], (L, DEC_BATCH, N_MEM, X_HEADS, X_HEAD_DIM), 1.0),
        'cache_mem_v': nrm(ks[8], (L, DEC_BATCH, N_MEM, X_HEADS, X_HEAD_DIM), 1.0),
        'norm_mix': gain(ks[9], (L, D_MODEL)),
        'w_in': nrm(ks[10], (L, D_MODEL, IN_DIM), D_MODEL ** -0.5),
        'conv_w': nrm(ks[11], (L, CONV_WIDTH, CONV_DIM), CONV_WIDTH ** -0.5),
        'conv_b': nrm(ks[12], (L, CONV_DIM), 0.02),
        'dt_bias': dt_bias,
        'a_log': a_log,
        'd_skip': gain(ks[15], (L, SSM_HEADS)),
        'gate_norm': gain(ks[16], (L, SSM_WIDTH)),
        'sinks': nrm(ks[17], (L, ATT_HEADS), 0.5),
        'w_out': nrm(ks[18], (L, MIX_WIDTH, D_MODEL), MIX_WIDTH ** -0.5),
        'norm_mem': gain(ks[19], (L, D_MODEL)),
        'norm_x': gain(ks[20], (L, D_MODEL)),
        'w_xq': nrm(ks[21], (L, D_MODEL, X_WIDTH), D_MODEL ** -0.5),
        'w_xk': nrm(ks[22], (L, D_MODEL, X_WIDTH), D_MODEL ** -0.5),
        'w_xv': nrm(ks[23], (L, D_MODEL, X_WIDTH), D_MODEL ** -0.5),
        'w_xo': nrm(ks[24], (L, X_WIDTH, D_MODEL), X_WIDTH ** -0.5),
        'norm_ffn': gain(ks[25], (L, D_MODEL)),
        'w_gate': nrm(ks[26], (L, D_MODEL, D_FF), D_MODEL ** -0.5),
        'w_up': nrm(ks[27], (L, D_MODEL, D_FF), D_MODEL ** -0.5),
        'w_down': nrm(ks[28], (L, D_FF, D_MODEL), D_FF ** -0.5),
        'norm_final': gain(ks[29], (D_MODEL,)),
    }


def reference(x_prompt, x_sample, mem_prompt, state_ssm, state_conv, cache_swa_k, cache_swa_v,
              cache_mem_k, cache_mem_v, norm_mix, w_in, conv_w, conv_b, dt_bias, a_log, d_skip,
              gate_norm, sinks, w_out, norm_mem, norm_x, w_xq, w_xk, w_xv, w_xo, norm_ffn,
              w_gate, w_up, w_down, norm_final):
    bp, tp = x_prompt.shape[0], x_prompt.shape[1]
    pos_p = jnp.arange(tp)
    pos_s = PAST_LEN + jnp.arange(x_sample.shape[1])
    xp, xs = x_prompt, x_sample
    p_ssm, p_conv, p_k, p_v, p_mk, p_mv = [], [], [], [], [], []
    s_ssm, s_conv, s_k, s_v = [], [], [], []
    for l in range(DEPTH):
        lp = {'norm_mix': norm_mix[l], 'w_in': w_in[l], 'conv_w': conv_w[l], 'conv_b': conv_b[l],
              'dt_bias': dt_bias[l], 'a_log': a_log[l], 'd_skip': d_skip[l], 'gate_norm': gate_norm[l],
              'sinks': sinks[l], 'w_out': w_out[l], 'norm_mem': norm_mem[l], 'norm_x': norm_x[l],
              'w_xq': w_xq[l], 'w_xk': w_xk[l], 'w_xv': w_xv[l], 'w_xo': w_xo[l],
              'norm_ffn': norm_ffn[l], 'w_gate': w_gate[l], 'w_up': w_up[l], 'w_down': w_down[l]}
        mk_p, mv_p = memory_kv(mem_prompt, lp)
        ssm0 = jnp.zeros((bp, SSM_HEADS, SSM_HEADDIM, D_STATE), x_prompt.dtype)
        conv0 = jnp.zeros((bp, CONV_WIDTH - 1, CONV_DIM), x_prompt.dtype)
        xp, a1, a2, a3, a4 = layer(xp, pos_p, ssm0, conv0, None, None, mk_p, mv_p, lp)
        p_ssm.append(a1); p_conv.append(a2); p_k.append(a3); p_v.append(a4)
        p_mk.append(mk_p); p_mv.append(mv_p)
        xs, b1, b2, b3, b4 = layer(xs, pos_s, state_ssm[l], state_conv[l], cache_swa_k[l], cache_swa_v[l],
                                   cache_mem_k[l], cache_mem_v[l], lp)
        s_ssm.append(b1); s_conv.append(b2); s_k.append(b3); s_v.append(b4)
    y_prompt = rmsnorm(xp, norm_final)
    y_sample = rmsnorm(xs, norm_final)
    return (y_prompt, y_sample,
            jnp.stack(p_ssm), jnp.stack(p_conv), jnp.stack(p_k), jnp.stack(p_v),
            jnp.stack(p_mk), jnp.stack(p_mv),
            jnp.stack(s_ssm), jnp.stack(s_conv), jnp.stack(s_k), jnp.stack(s_v))
```

```cpp
#include <hip/hip_runtime.h>
#include <cstdio>
#include <cstdint>
#include <cmath>
namespace pg8 {
#define PG8_LAS __attribute__((address_space(3)))
typedef unsigned short bf16_t;
typedef short bf16x8 __attribute__((ext_vector_type(8)));
typedef float f32x4 __attribute__((ext_vector_type(4)));
typedef unsigned u32x4 __attribute__((ext_vector_type(4)));
constexpr int BM = 256, BK = 64, HALF = 128, HTB = HALF * BK * 2  , STAGE_BYTES = 8 * HTB, NXCD = 8, WGM = 8;

__host__ __device__ __forceinline__ int lds_byte(int r, int c) { const int st = (r >> 4) * 2 + (c >> 5), rr = r & 15, cc = c & 31, ob = rr * 64 + cc * 2; return st * 1024 + (ob ^ (((ob >> 9) & 1) << 5)); }
__host__ __device__ __forceinline__ void stage_rc(int b, int& R, int& C) { const int st = b / 1024, sb = b % 1024, swz = sb ^ (((sb >> 9) & 1) << 5); R = (st >> 1) * 16 + swz / 64; C = (st & 1) * 32 + (swz % 64) / 2; }
__host__ __device__ __forceinline__ int perm32(int rho) { const int n = rho >> 4, i = rho & 15; return 8 * (i >> 2) + 4 * n + (i & 3); }

struct Unit { int pm, pn; };
struct Gemm { const bf16_t* A; const bf16_t* Bt; int M, N, K; };

struct StaticOrder {
    int nM, nN, nwg, G, c;
    __host__ __device__ void init(int M, int N, int G_, int c_) { nM = M / BM; nN = N / BM; nwg = nM * nN; G = G_; c = c_; }
    __host__ __device__ bool next(int i, Unit& u) const {
        const long L = (long)i * G + c; if (L >= nwg) return false;
        int wgid = (int)L; { const int q = nwg / NXCD, r = nwg % NXCD, xcd = wgid % NXCD, off = wgid / NXCD; wgid = (xcd < r ? xcd * (q + 1) : r * (q + 1) + (xcd - r) * q) + off; }
        const int nig = WGM * nN, gid = wgid / nig, fm = gid * WGM, gsz = (nM - fm) < WGM ? (nM - fm) : WGM;
        u.pm = fm + ((wgid % nig) % gsz); u.pn = (wgid % nig) / gsz; return true;
    }
    __device__ __forceinline__ void a_ready(const Unit&) const {}
    __device__ __forceinline__ void done(const Unit&) const {}
};

__device__ __forceinline__ unsigned cvt_pk_bf16(float lo, float hi) { unsigned r; asm volatile("v_cvt_pk_bf16_f32 %0, %1, %2" : "=v"(r) : "v"(lo), "v"(hi)); return r; }
typedef unsigned u32x2 __attribute__((ext_vector_type(2)));
constexpr float RMS_EPS = 1e-5f;
constexpr int ROWS_P = 8192;
struct EpiBf16S {
    static constexpr bool PERM = true, AFTER_DRAIN = false;
    bf16_t* O; int ldc; const float* ssq;
    __device__ __forceinline__ void operator()(const f32x4 (&acc)[2][2][4][2], const Unit& u, int wr, int wc, int fr, int fq) const {
        const int row0 = u.pm * BM + wr * 64 + fr, col0 = u.pn * BM + wc * 32 + 8 * fq;
#pragma unroll
        for (int ai = 0; ai < 2; ++ai)
#pragma unroll
            for (int m = 0; m < 4; ++m) { const int r = row0 + ai * HALF + m * 16; bf16_t* rowp = O + (size_t)r * ldc + col0;
                const float sc = ssq ? 1.0f / sqrtf(ssq[r] * (1.0f / 2048.0f) + RMS_EPS) : 1.0f;
#pragma unroll
                for (int bj = 0; bj < 2; ++bj) { const f32x4 v0 = acc[ai][bj][m][0] * sc, v1 = acc[ai][bj][m][1] * sc;
                    u32x4 w; w.x = cvt_pk_bf16(v0[0], v0[1]); w.y = cvt_pk_bf16(v0[2], v0[3]); w.z = cvt_pk_bf16(v1[0], v1[1]); w.w = cvt_pk_bf16(v1[2], v1[3]);
                    *(u32x4*)(rowp + bj * HALF) = w; } }
    }
};
struct EpiSwiGLU {
    static constexpr bool PERM = true, AFTER_DRAIN = false;
    bf16_t* O; int ldc; const float* ssq;
    __device__ __forceinline__ void operator()(const f32x4 (&acc)[2][2][4][2], const Unit& u, int wr, int wc, int fr, int fq) const {
        const int row0 = u.pm * BM + wr * 64 + fr, col0 = u.pn * 128 + wc * 16 + 4 * fq;
#pragma unroll
        for (int ai = 0; ai < 2; ++ai)
#pragma unroll
            for (int m = 0; m < 4; ++m) { const int r = row0 + ai * HALF + m * 16; bf16_t* rowp = O + (size_t)r * ldc + col0;
                const float sc = 1.0f / sqrtf(ssq[r] * (1.0f / 2048.0f) + RMS_EPS);
#pragma unroll
                for (int bj = 0; bj < 2; ++bj) { const f32x4 g = acc[ai][bj][m][0] * sc, up = acc[ai][bj][m][1] * sc; f32x4 a;
#pragma unroll
                    for (int i = 0; i < 4; ++i) a[i] = g[i] * __builtin_amdgcn_rcpf(1.0f + __builtin_amdgcn_exp2f(-1.4426950408889634f * g[i])) * up[i];
                    u32x2 w; w.x = cvt_pk_bf16(a[0], a[1]); w.y = cvt_pk_bf16(a[2], a[3]);
                    *(u32x2*)(rowp + bj * 64) = w; } }
    }
};
struct EpiResid {
    static constexpr bool PERM = false, AFTER_DRAIN = false;
    const float* baseP; const float* baseS; float* out; bf16_t* ob; float* ssq;
    __device__ __forceinline__ void operator()(const f32x4 (&acc)[2][2][4][2], const Unit& u, int wr, int wc, int fr, int fq) const {
        const int row0 = u.pm * BM + wr * 64 + fr, col0 = u.pn * BM + wc * 32 + 4 * fq;
#pragma unroll
        for (int ai = 0; ai < 2; ++ai)
#pragma unroll
            for (int m = 0; m < 4; ++m) { const int r = row0 + ai * HALF + m * 16; const size_t off = (size_t)r * 2048 + col0;
                const float* bp = (r < ROWS_P) ? baseP + off : baseS + (off - (size_t)ROWS_P * 2048);
                float s = 0.f;
#pragma unroll
                for (int bj = 0; bj < 2; ++bj)
#pragma unroll
                    for (int n = 0; n < 2; ++n) { const f32x4 v = acc[ai][bj][m][n] + *(const f32x4*)(bp + bj * HALF + n * 16);
                        *(f32x4*)(out + off + bj * HALF + n * 16) = v; s += (v[0] * v[0] + v[1] * v[1]) + (v[2] * v[2] + v[3] * v[3]);
                        if (ob) { u32x2 w; w.x = cvt_pk_bf16(v[0], v[1]); w.y = cvt_pk_bf16(v[2], v[3]); *(u32x2*)(ob + off + bj * HALF + n * 16) = w; } }
                s += __shfl_xor(s, 16); s += __shfl_xor(s, 32);
                if (fq == 0) atomicAdd(ssq + r, s); }
    }
};
struct EpiMemKV {
    static constexpr bool PERM = false, AFTER_DRAIN = false;
    float* pmk; float* pmv; bf16_t* ob;
    __device__ __forceinline__ void operator()(const f32x4 (&acc)[2][2][4][2], const Unit& u, int wr, int wc, int fr, int fq) const {
        const int row0 = u.pm * BM + wr * 64 + fr, col0 = u.pn * BM + wc * 32 + 4 * fq, c512 = (u.pn & 1) * BM + wc * 32 + 4 * fq;
        float* dst = (u.pn < 2) ? pmk : pmv;
#pragma unroll
        for (int ai = 0; ai < 2; ++ai)
#pragma unroll
            for (int m = 0; m < 4; ++m) { const int r = row0 + ai * HALF + m * 16;
#pragma unroll
                for (int bj = 0; bj < 2; ++bj)
#pragma unroll
                    for (int n = 0; n < 2; ++n) { const f32x4 v = acc[ai][bj][m][n];
                        *(f32x4*)(dst + (size_t)r * 512 + c512 + bj * HALF + n * 16) = v;
                        u32x2 w; w.x = cvt_pk_bf16(v[0], v[1]); w.y = cvt_pk_bf16(v[2], v[3]); *(u32x2*)(ob + (size_t)r * 1024 + col0 + bj * HALF + n * 16) = w; } }
    }
};

template <class Epi, class Sched, bool ALIGN_EPI = false, bool SP2 = false>
__device__ __forceinline__ void gemm_phase(PG8_LAS unsigned char* lds, const Gemm g, const Sched& S, const Epi& E) {
    const int tid = threadIdx.x, wid = __builtin_amdgcn_readfirstlane(tid >> 6), lane = tid & 63, wr = wid >> 2, wc = wid & 3, fr = lane & 15, fq = lane >> 4;
    const int K = g.K, nt = K / BK;
    unsigned voffA[2], voffB[2];
#pragma unroll
    for (int i = 0; i < 2; ++i) { int R, C; stage_rc(tid * 16 + i * 8192, R, C); const int Rb = Epi::PERM ? ((R & ~31) + perm32(R & 31)) : R;
        voffA[i] = (unsigned)(R * K + C) * 2u; voffB[i] = (unsigned)(Rb * K + C) * 2u; }
    const size_t kstep = (size_t)(BK * 2);
    const size_t hstep = (size_t)HALF * K * 2;
    const size_t tstep = 2 * hstep;
    const unsigned ldsw = (unsigned)wid * 1024u;
    const int aoff = lds_byte(wr * 64 + fr, fq * 8), boff = lds_byte(wc * 32 + fr, fq * 8);
#define PG8_SA(b, h) (((b) * 2 + (h)) * HTB)
#define PG8_SB(b, h) ((4 + (b) * 2 + (h)) * HTB)
#define PG8_STAGE(bufoff, gbase, voff) do { _Pragma("unroll") for (int _i = 0; _i < 2; ++_i) \
        __builtin_amdgcn_global_load_lds((const unsigned*)((const char*)(gbase) + (voff)[_i]), (PG8_LAS unsigned*)(lds + (bufoff) + ldsw + _i * 8192), 16, 0, 0); } while (0)
#define PG8_LDA(dst, b, h) do { _Pragma("unroll") for (int m = 0; m < 4; ++m) _Pragma("unroll") for (int k = 0; k < 2; ++k) dst[m][k] = *(const PG8_LAS bf16x8*)(lds + PG8_SA(b, h) + aoff + m * 2048 + k * 1024); } while (0)
#define PG8_LDB(dst, b, h) do { _Pragma("unroll") for (int n = 0; n < 2; ++n) _Pragma("unroll") for (int k = 0; k < 2; ++k) dst[n][k] = *(const PG8_LAS bf16x8*)(lds + PG8_SB(b, h) + boff + n * 2048 + k * 1024); } while (0)
#define PG8_MMA(ai, bj, At, Bt) do { __builtin_amdgcn_s_setprio(1); _Pragma("unroll") for (int m = 0; m < 4; ++m) _Pragma("unroll") for (int n = 0; n < 2; ++n) _Pragma("unroll") for (int k = 0; k < 2; ++k) \
        acc[ai][bj][m][n] = __builtin_amdgcn_mfma_f32_16x16x32_bf16(Bt[n][k], At[m][k], acc[ai][bj][m][n], 0, 0, 0); __builtin_amdgcn_s_setprio(0); } while (0)
#define PG8_WAIT_V(n) asm volatile("s_waitcnt vmcnt(" #n ")" ::: "memory")
#define PG8_WAIT_L(n) asm volatile("s_waitcnt lgkmcnt(" #n ")" ::: "memory")
#define PG8_BAR __builtin_amdgcn_s_barrier()
#define PG8_SCHED __builtin_amdgcn_sched_barrier(0)
    Unit cur, nxt; int ui = 0;
    if (!S.next(0, cur)) return;
    f32x4 acc[2][2][4][2];
#pragma unroll
    for (int a = 0; a < 2; ++a)
#pragma unroll
        for (int b = 0; b < 2; ++b)
#pragma unroll
            for (int m = 0; m < 4; ++m)
#pragma unroll
                for (int n = 0; n < 2; ++n) acc[a][b][m][n] = (f32x4){0.f, 0.f, 0.f, 0.f};
    bf16x8 At[4][2], B0[2][2], B1[2][2];
    const char* cA = (const char*)g.A + (size_t)cur.pm * tstep; const char* cB = (const char*)g.Bt + (size_t)cur.pn * tstep;
    S.a_ready(cur);
    if constexpr (SP2) {
        PG8_STAGE(PG8_SB(0, 0), cB, voffB); PG8_STAGE(PG8_SB(0, 1), cB + hstep, voffB); PG8_STAGE(PG8_SA(0, 0), cA, voffA); PG8_STAGE(PG8_SA(0, 1), cA + hstep, voffA);
        if (wr == 1) PG8_BAR;
        PG8_WAIT_V(2); PG8_BAR;
        PG8_STAGE(PG8_SB(1, 0), cB + kstep, voffB); PG8_STAGE(PG8_SA(1, 0), cA + kstep, voffA); PG8_STAGE(PG8_SB(1, 1), cB + hstep + kstep, voffB);
        PG8_WAIT_V(6); PG8_BAR;
    } else {
        PG8_STAGE(PG8_SB(0, 0), cB, voffB); PG8_STAGE(PG8_SA(0, 0), cA, voffA); PG8_STAGE(PG8_SB(0, 1), cB + hstep, voffB); PG8_STAGE(PG8_SA(0, 1), cA + hstep, voffA);
        if (wr == 1) PG8_BAR;
        PG8_WAIT_V(4); PG8_BAR;
        PG8_STAGE(PG8_SB(1, 0), cB + kstep, voffB); PG8_STAGE(PG8_SA(1, 0), cA + kstep, voffA); PG8_STAGE(PG8_SB(1, 1), cB + hstep + kstep, voffB);
        PG8_WAIT_V(6); PG8_BAR;
    }
    for (;;) {
        const bool has_next = S.next(ui + 1, nxt);
        const char* nA = has_next ? (const char*)g.A + (size_t)nxt.pm * tstep : cA; const char* nB = has_next ? (const char*)g.Bt + (size_t)nxt.pn * tstep : cB;
        for (int t = 0; t < nt; t += 2) {
            const bool last = (t == nt - 2);
            const char* a1 = cA + (size_t)(t + 1) * kstep;
            const char* a2 = last ? nA : cA + (size_t)(t + 2) * kstep; const char* b2 = last ? nB : cB + (size_t)(t + 2) * kstep;
            const char* a3 = a2 + kstep; const char* b3 = b2 + kstep;
            if (last && has_next) S.a_ready(nxt);
            if constexpr (SP2) {
            PG8_LDB(B0, 0, 0); PG8_LDB(B1, 0, 1); PG8_SCHED; PG8_LDA(At, 0, 0); PG8_STAGE(PG8_SA(1, 1), a1 + hstep, voffA);
            PG8_WAIT_V(8); PG8_WAIT_L(0); PG8_BAR; PG8_MMA(0, 0, At, B0); PG8_MMA(0, 1, At, B1); PG8_BAR; PG8_SCHED;
            PG8_LDA(At, 0, 1); PG8_STAGE(PG8_SB(0, 0), b2, voffB); PG8_STAGE(PG8_SB(0, 1), b2 + hstep, voffB); PG8_STAGE(PG8_SA(0, 0), a2, voffA);
            PG8_WAIT_V(8); PG8_WAIT_L(0); PG8_BAR; PG8_MMA(1, 0, At, B0); PG8_MMA(1, 1, At, B1); PG8_BAR; PG8_SCHED;
            PG8_LDB(B0, 1, 0); PG8_LDB(B1, 1, 1); PG8_SCHED; PG8_LDA(At, 1, 0); PG8_STAGE(PG8_SA(0, 1), a2 + hstep, voffA);
            PG8_WAIT_V(8); PG8_WAIT_L(0); PG8_BAR; PG8_MMA(0, 0, At, B0); PG8_MMA(0, 1, At, B1); PG8_BAR; PG8_SCHED;
            PG8_LDA(At, 1, 1); PG8_STAGE(PG8_SB(1, 0), b3, voffB); PG8_STAGE(PG8_SB(1, 1), b3 + hstep, voffB); PG8_STAGE(PG8_SA(1, 0), a3, voffA);
            PG8_WAIT_V(8); PG8_WAIT_L(0); PG8_BAR; PG8_MMA(1, 0, At, B0); PG8_MMA(1, 1, At, B1); PG8_BAR; PG8_SCHED;
            } else {
            PG8_LDB(B0, 0, 0); PG8_SCHED; PG8_LDA(At, 0, 0); PG8_STAGE(PG8_SA(1, 1), a1 + hstep, voffA);
            PG8_WAIT_L(8); PG8_BAR; PG8_WAIT_L(0); PG8_MMA(0, 0, At, B0); PG8_BAR; PG8_SCHED;
            PG8_LDB(B1, 0, 1); PG8_STAGE(PG8_SB(0, 0), b2, voffB);
            PG8_BAR; PG8_WAIT_L(0); PG8_MMA(0, 1, At, B1); PG8_BAR;
            PG8_LDA(At, 0, 1); PG8_STAGE(PG8_SA(0, 0), a2, voffA);
            PG8_BAR; PG8_WAIT_L(0); PG8_MMA(1, 0, At, B0); PG8_BAR; PG8_SCHED;
            PG8_STAGE(PG8_SB(0, 1), b2 + hstep, voffB);
            PG8_WAIT_V(6); PG8_BAR; PG8_MMA(1, 1, At, B1); PG8_BAR;
            PG8_LDB(B0, 1, 0); PG8_SCHED; PG8_LDA(At, 1, 0); PG8_STAGE(PG8_SA(0, 1), a2 + hstep, voffA);
            PG8_WAIT_L(8); PG8_BAR; PG8_WAIT_L(0); PG8_MMA(0, 0, At, B0); PG8_BAR; PG8_SCHED;
            PG8_LDB(B1, 1, 1); PG8_STAGE(PG8_SB(1, 0), b3, voffB);
            PG8_BAR; PG8_WAIT_L(0); PG8_MMA(0, 1, At, B1); PG8_BAR;
            PG8_LDA(At, 1, 1); PG8_STAGE(PG8_SA(1, 0), a3, voffA);
            PG8_BAR; PG8_WAIT_L(0); PG8_MMA(1, 0, At, B0); PG8_BAR; PG8_SCHED;
            PG8_STAGE(PG8_SB(1, 1), b3 + hstep, voffB);
            PG8_WAIT_V(6); PG8_BAR; PG8_MMA(1, 1, At, B1); PG8_BAR;
            }
        }
        if constexpr (ALIGN_EPI) { if (wr == 0) PG8_BAR; }
        if constexpr (!Epi::AFTER_DRAIN) { E(acc, cur, wr, wc, fr, fq); S.done(cur); }
        if (!has_next) break;
#pragma unroll
        for (int a = 0; a < 2; ++a)
#pragma unroll
            for (int b = 0; b < 2; ++b)
#pragma unroll
                for (int m = 0; m < 4; ++m)
#pragma unroll
                    for (int n = 0; n < 2; ++n) acc[a][b][m][n] = (f32x4){0.f, 0.f, 0.f, 0.f};
        cur = nxt; cA = nA; cB = nB; ++ui;
        if constexpr (ALIGN_EPI) { if (wr == 1) PG8_BAR; }
    }
    PG8_WAIT_V(0);
    if constexpr (!ALIGN_EPI) { if (wr == 0) PG8_BAR; }
    PG8_BAR;
    if constexpr (Epi::AFTER_DRAIN) { E.fused(acc, cur, wr, wc, fr, fq, lds, wid, lane); S.done(cur); }
#undef PG8_SA
#undef PG8_SB
#undef PG8_STAGE
#undef PG8_LDA
#undef PG8_LDB
#undef PG8_MMA
#undef PG8_WAIT_V
#undef PG8_WAIT_L
#undef PG8_BAR
#undef PG8_SCHED
}
}
#ifndef PG8_SP2
#define PG8_SP2 true
#endif
#ifndef PG8_ALIGN
#define PG8_ALIGN true
#endif
constexpr int NWAVES = 8;
#ifndef MK_ONE_LAUNCH
#define MK_ONE_LAUNCH 0
#endif
constexpr int NPHASE = 12;

constexpr int DM = 2048, SEQ = 2048, NBP = 4, NBS = 128, TS = 4;
constexpr int MP = NBP * SEQ, MS = NBS * TS, M = MP + MS;
constexpr int NMEM = 256, MM = NBP * NMEM;
constexpr int IN_DIM = 3856, NPROJ = 3840;
constexpr int C_Z = 0, C_X = 1024, C_B = 2048, C_C = 2304, C_Q = 2560, C_K = 3584, C_V = 3712;
constexpr int W_DT = 2560;
constexpr int CONVD = 1536, XW = 512, DFF = 5632, NHS = 16, HD = 64, DST = 128, WIN = 128;
constexpr float EPS = 1e-5f;
constexpr int PAST = 16384;
constexpr size_t O_Y = 0, O_PSSM = 17825792, O_PCONV = 18350080, O_PSK = 18368512, O_PSV = 18434048, O_PMK = 18499584, O_PMV = 19023872,
                 O_SSSM = 19548160, O_SCONV = 36325376, O_SSK = 36915200, O_SSV = 39012352, O_END = 41109504;

constexpr size_t MiB = 1u << 20;
constexpr size_t WS_CTL = 0, CTL_ZERO_BYTES = 1 * MiB;
constexpr size_t WS_DT = 1 * MiB;
constexpr size_t WS_ROPE = 2 * MiB;
constexpr size_t WS_WIN = 8 * MiB, WS_WKV = 23 * MiB, WS_WOUT = 27 * MiB, WS_WXQ = 35 * MiB, WS_WXO = 37 * MiB, WS_WGU = 39 * MiB, WS_WDN = 83 * MiB;
constexpr size_t WS_XB = 105 * MiB;
constexpr size_t WS_MN = 139 * MiB;
constexpr size_t WS_MKV = 143 * MiB;
constexpr size_t WS_YATT = 145 * MiB;
constexpr size_t WS_QX = 179 * MiB, WS_OX = 188 * MiB;
constexpr size_t WS_PROJ = 197 * MiB;
constexpr size_t WS_ACT = 197 * MiB;
constexpr size_t WS_YG = 291 * MiB;
constexpr size_t WS_XC = 326 * MiB;
constexpr size_t WS_END = 352 * MiB;
constexpr int CW_TMO = 0, CW_CODE = 1;
constexpr int CW_BAR = 4096;
constexpr int CW_SSQ1 = 16384, CW_SSQ2 = CW_SSQ1 + 8704, CW_SSQ3 = CW_SSQ2 + 8704;
static_assert((CW_SSQ3 + 8704) * 4 <= (int)CTL_ZERO_BYTES, "CTL words inside the memset region");

constexpr int RING_OFF = 0, RING_BYTES = 131072;
constexpr int LDSCTL_OFF = RING_BYTES, MISC_OFF = LDSCTL_OFF + 320;
constexpr int LDS_BYTES = 147456;
static_assert(MISC_OFF + 128 <= LDS_BYTES, "LDS map");

#define GAS __attribute__((address_space(1)))
#define LAS __attribute__((address_space(3)))
typedef unsigned short bf16;
typedef unsigned v4u __attribute__((ext_vector_type(4)));
typedef float f32x4 __attribute__((ext_vector_type(4)));
typedef short bf16x8 __attribute__((ext_vector_type(8)));
typedef GAS unsigned gu32;
typedef GAS unsigned long long gu64;
#define RLX_AGENT __ATOMIC_RELAXED, __HIP_MEMORY_SCOPE_AGENT
#define LDS_WAIT() asm volatile("s_waitcnt lgkmcnt(0)" ::: "memory")
#define VM_WAIT() asm volatile("s_waitcnt vmcnt(0)" ::: "memory")
__device__ __forceinline__ unsigned long long rt() { return __builtin_amdgcn_s_memrealtime(); }
__device__ __forceinline__ unsigned f2bf(float f) { unsigned u = __builtin_bit_cast(unsigned, f); return (u + 0x7fffu + ((u >> 16) & 1u)) >> 16; }
__device__ __forceinline__ unsigned pk2(float lo, float hi) { return f2bf(lo) | (f2bf(hi) << 16); }

#define XB_TMO      128
#define XB_XCNT(j)  (256  + 64 * (j))
#define XB_XSUB(j)  (1280 + 64 * (j))
#define XB_XGEN(j)  (2304 + 64 * (j))
#define XB_TOP      3328
#define XB_TOPGEN   3392
#define XCD_BAR_WORDS 3456
#define XB_SPIN_CAP (1u << 18)

__device__ __forceinline__ unsigned xb_ld(unsigned* p)              { return __hip_atomic_load(p, __ATOMIC_RELAXED, __HIP_MEMORY_SCOPE_AGENT); }
__device__ __forceinline__ unsigned xb_add(unsigned* p, unsigned v) { return __hip_atomic_fetch_add(p, v, __ATOMIC_RELAXED, __HIP_MEMORY_SCOPE_AGENT); }
__device__ __forceinline__ unsigned xb_xcc_id() { return (unsigned)__builtin_amdgcn_s_getreg((3 << 11) | 20) & 0xFu; }
#define XB_SPIN(cond, bar) do { unsigned _sp = 0; while (cond) { __builtin_amdgcn_s_sleep(1); \
    if ((++_sp & 255u) == 0u) { if (xb_ld(&(bar)[XB_TMO])) break; if (_sp > XB_SPIN_CAP) { atomicAdd(&(bar)[XB_TMO], 1u); break; } } } } while (0)

struct XcdBarrier {
    unsigned* bar; unsigned x;
    volatile LAS unsigned* st;
};

__device__ __forceinline__ XcdBarrier xcd_barrier_post(unsigned* bar, volatile LAS unsigned* st) {
    XcdBarrier b; b.bar = bar; b.x = xb_xcc_id(); b.st = st;
    if (threadIdx.x == 0) (void)xb_add(&bar[XB_XCNT(b.x)], 1u);
    return b;
}
__device__ __forceinline__ void xcd_barrier_complete(unsigned* bar, unsigned x, unsigned& nloc, unsigned& nx) {
    const unsigned G = gridDim.x * gridDim.y * gridDim.z;
    unsigned sum, cnt, mine, sp = 0u;
    for (;;) {
        sum = 0u; cnt = 0u; mine = 0u;
#pragma unroll
        for (unsigned j = 0; j < 16; ++j) { const unsigned c = xb_ld(&bar[XB_XCNT(j)]); sum += c; cnt += (c > 0u) ? 1u : 0u; mine = (j == x) ? c : mine; }
        if (sum == G) break;
        __builtin_amdgcn_s_sleep(1);
        if ((++sp & 255u) == 0u) { if (xb_ld(&bar[XB_TMO])) break; if (sp > XB_SPIN_CAP) { atomicAdd(&bar[XB_TMO], 1u); break; } }
    }
    nloc = mine > 0u ? mine : 1u; nx = cnt > 0u ? cnt : 1u;
}

__device__ __forceinline__ void xcd_barrier(const XcdBarrier& b) {
    asm volatile("s_waitcnt vmcnt(0)" ::: "memory");
    __syncthreads();
    if (threadIdx.x == 0) {
        unsigned* bar = b.bar;
        __builtin_amdgcn_s_waitcnt(0);
        unsigned nloc = b.st[0], nx = b.st[1];
        if (nloc == 0u) { xcd_barrier_complete(bar, b.x, nloc, nx); b.st[0] = nloc; b.st[1] = nx; }
        const unsigned old = xb_add(&bar[XB_XSUB(b.x)], 1u);
        const unsigned gen = old / nloc;
        if (old + 1u == (gen + 1u) * nloc) {
            __builtin_amdgcn_fence(__ATOMIC_RELEASE, "agent");
            asm volatile("s_waitcnt vmcnt(0)" ::: "memory");
            const unsigned og = xb_add(&bar[XB_TOP], 1u);
            const unsigned tg = og / nx;
            if (og + 1u == (tg + 1u) * nx) xb_add(&bar[XB_TOPGEN], 1u);
            else XB_SPIN(xb_ld(&bar[XB_TOPGEN]) == tg, bar);
            __builtin_amdgcn_fence(__ATOMIC_ACQUIRE, "agent");
            xb_add(&bar[XB_XGEN(b.x)], 1u);
            asm volatile("s_waitcnt vmcnt(0)" ::: "memory");
        } else {
            XB_SPIN(xb_ld(&bar[XB_XGEN(b.x)]) == gen, bar);
            __builtin_amdgcn_fence(__ATOMIC_ACQUIRE, "agent");
            asm volatile("s_waitcnt vmcnt(0)" ::: "memory");
        }
    }
    __syncthreads();
}
struct Frame {
    unsigned char* lds;
    LAS unsigned char* ldsl;
    volatile LAS unsigned* MISC;
    gu32* ctl;
    int tid, lane, wave, G;
    const float* in[30]; float* out; unsigned char* ws;
    bf16 *Wt_in, *Wt_kv, *Wt_out, *Wt_xq, *Wt_xo, *Wt_gu, *Wt_dn;
    bf16 *XB, *MN, *MKV, *YATT, *QX, *OX, *PROJ, *ACT, *XC;
    float *DT, *ROPE, *YG, *SSQ1, *SSQ2, *SSQ3;
};
enum { I_XP = 0, I_XS, I_MEM, I_SSSM, I_SCONV, I_CSK, I_CSV, I_CMK, I_CMV, I_NMIX, I_WIN, I_CONVW, I_CONVB, I_DTB, I_ALOG, I_DSKIP, I_GNORM, I_SINKS,
       I_WOUT, I_NMEM, I_NX, I_WXQ, I_WXK, I_WXV, I_WXO, I_NFFN, I_WGATE, I_WUP, I_WDOWN, I_NFINAL };

__device__ __forceinline__ float bf2f(unsigned u16) { return __uint_as_float(u16 << 16); }
__device__ __forceinline__ void unpack8(const v4u& v, float (&f)[8]) {
    f[0] = __uint_as_float(v.x << 16); f[1] = __uint_as_float(v.x & 0xffff0000u); f[2] = __uint_as_float(v.y << 16); f[3] = __uint_as_float(v.y & 0xffff0000u);
    f[4] = __uint_as_float(v.z << 16); f[5] = __uint_as_float(v.z & 0xffff0000u); f[6] = __uint_as_float(v.w << 16); f[7] = __uint_as_float(v.w & 0xffff0000u);
}
__device__ __forceinline__ v4u pack8(const float (&f)[8]) { v4u o; o.x = pk2(f[0], f[1]); o.y = pk2(f[2], f[3]); o.z = pk2(f[4], f[5]); o.w = pk2(f[6], f[7]); return o; }
__device__ __forceinline__ float wave_sum(float v) {
#pragma unroll
    for (int o = 1; o < 64; o <<= 1) v += __shfl_xor(v, o);
    return v;
}
__device__ __forceinline__ float silu_f(float x) { return x / (1.0f + __expf(-x)); }

__device__ __forceinline__ void p0_transpose_item(const float* W, int ldw, int col0, int K, int N, bf16* WT, int mode, int rowoff, const float* ks, float* scr, int item, int lane) {
    const int nblk = N / 32, kb = item / nblk, nb = item % nblk, k0 = 64 * kb, n0 = 32 * nb;
#pragma unroll 8
    for (int i = 0; i < 32; ++i) { const int kk = 2 * i + (lane >> 5); float v = W[(size_t)(k0 + kk) * ldw + col0 + n0 + (lane & 31)]; if (ks) v *= ks[k0 + kk]; scr[kk * 33 + (lane & 31)] = v; }
    LDS_WAIT(); asm volatile("" ::: "memory");
    const int c = lane & 7;
#pragma unroll
    for (int j = 0; j < 4; ++j) { const int n = (lane >> 3) + 8 * j; const float* s = scr + (8 * c) * 33 + n; const int nn = n0 + n;
        const int drow = (mode == 0) ? rowoff + nn : 256 * (nn >> 7) + 8 * ((nn & 127) >> 2) + (nn & 3) + rowoff;
        v4u o; o.x = pk2(s[0 * 33], s[1 * 33]); o.y = pk2(s[2 * 33], s[3 * 33]); o.z = pk2(s[4 * 33], s[5 * 33]); o.w = pk2(s[6 * 33], s[7 * 33]);
        *(v4u*)(WT + (size_t)drow * K + k0 + 8 * c) = o; }
    LDS_WAIT(); asm volatile("" ::: "memory");
}
__device__ __forceinline__ void p0_prologue(Frame& F) {
    const int gw = blockIdx.x * NWAVES + F.wave, NGW = F.G * NWAVES;
    float* scr = (float*)(F.lds + RING_OFF + F.wave * 16384);
    constexpr int I0 = 32 * 80, I1 = 32 * 40, I2 = 512, I3 = 512, I4 = 2048, I5 = 512, I6 = 512, I7 = 5632, I8 = 5632, I9 = 5632;
    constexpr int NITEMS = I0 + I1 + I2 + I3 + I4 + I5 + I6 + I7 + I8 + I9;
    for (int it = gw; it < NITEMS; it += NGW) {
        int r = it;
        if (r < I7) { p0_transpose_item(F.in[I_WGATE], DFF, 0, DM, DFF, F.Wt_gu, 1, 0, F.in[I_NFFN], scr, r, F.lane); continue; } r -= I7;
        if (r < I8) { p0_transpose_item(F.in[I_WUP], DFF, 0, DM, DFF, F.Wt_gu, 1, 4, F.in[I_NFFN], scr, r, F.lane); continue; } r -= I8;
        if (r < I9) { p0_transpose_item(F.in[I_WDOWN], DM, 0, DFF, DM, F.Wt_dn, 0, 0, nullptr, scr, r, F.lane); continue; } r -= I9;
        if (r < I0) { p0_transpose_item(F.in[I_WIN], IN_DIM, 0, DM, 2560, F.Wt_in, 0, 0, nullptr, scr, r, F.lane); continue; } r -= I0;
        if (r < I1) { p0_transpose_item(F.in[I_WIN], IN_DIM, 2576, DM, 1280, F.Wt_in, 0, 2560, nullptr, scr, r, F.lane); continue; } r -= I1;
        if (r < I2) { p0_transpose_item(F.in[I_WXK], XW, 0, DM, XW, F.Wt_kv, 0, 0, nullptr, scr, r, F.lane); continue; } r -= I2;
        if (r < I3) { p0_transpose_item(F.in[I_WXV], XW, 0, DM, XW, F.Wt_kv, 0, 512, nullptr, scr, r, F.lane); continue; } r -= I3;
        if (r < I4) { p0_transpose_item(F.in[I_WOUT], DM, 0, DM, DM, F.Wt_out, 0, 0, nullptr, scr, r, F.lane); continue; } r -= I4;
        if (r < I5) { p0_transpose_item(F.in[I_WXQ], XW, 0, DM, XW, F.Wt_xq, 0, 0, F.in[I_NX], scr, r, F.lane); continue; } r -= I5;
        p0_transpose_item(F.in[I_WXO], DM, 0, XW, DM, F.Wt_xo, 0, 0, nullptr, scr, r, F.lane);
    }
    for (int e = blockIdx.x * 512 + F.tid; e < 2052 * 8; e += F.G * 512) {
        const int idx = e >> 3, i = e & 7; const double pos = (double)(idx < 2048 ? idx : PAST + idx - 2048);
        const double ang = pos * pow(500000.0, -(double)i / 8.0);
        F.ROPE[2 * e] = (float)cos(ang); F.ROPE[2 * e + 1] = (float)sin(ang);
    }
    __syncthreads();
    float* wdt = (float*)(F.lds + RING_OFF);
    for (int e = F.tid; e < 16 * DM; e += 512) { const int h = e >> 11, k = e & 2047; wdt[h * DM + k] = F.in[I_WIN][(size_t)k * IN_DIM + W_DT + h]; }
    __syncthreads();
    for (int m = gw; m < M + MM; m += NGW) {
        const bool ismem = m >= M;
        const float* xrow = ismem ? F.in[I_MEM] + (size_t)(m - M) * DM : (m < MP ? F.in[I_XP] + (size_t)m * DM : F.in[I_XS] + (size_t)(m - MP) * DM);
        const float* gw_ = ismem ? F.in[I_NMEM] : F.in[I_NMIX];
        const f32x4* xr = (const f32x4*)xrow + F.lane; const f32x4* gr = (const f32x4*)gw_ + F.lane;
        f32x4 v[8]; float s = 0.f;
#pragma unroll
        for (int j = 0; j < 8; ++j) { v[j] = xr[64 * j]; s += (v[j].x * v[j].x + v[j].y * v[j].y) + (v[j].z * v[j].z + v[j].w * v[j].w); }
        const float rstd = 1.0f / sqrtf(wave_sum(s) * (1.0f / DM) + EPS);
#pragma unroll
        for (int j = 0; j < 8; ++j) { const f32x4 g = gr[64 * j]; v[j] = v[j] * rstd * g; }
        bf16* orow = ismem ? F.MN + (size_t)(m - M) * DM : F.XB + (size_t)m * DM;
        unsigned long long* o8 = (unsigned long long*)orow + F.lane;
#pragma unroll
        for (int j = 0; j < 8; ++j) o8[64 * j] = (unsigned long long)pk2(v[j].x, v[j].y) | ((unsigned long long)pk2(v[j].z, v[j].w) << 32);
        if (!ismem) {
            float mine = 0.f;
#pragma unroll
            for (int h = 0; h < 16; ++h) { float a = 0.f;
#pragma unroll
                for (int j = 0; j < 8; ++j) { const f32x4 w = *(const f32x4*)(wdt + h * DM + 4 * (64 * j + F.lane)); a += (v[j].x * w.x + v[j].y * w.y) + (v[j].z * w.z + v[j].w * w.w); }
                a = wave_sum(a); if (F.lane == h) mine = a; }
            if (F.lane < 16) { const float xx = mine + F.in[I_DTB][F.lane]; F.DT[(size_t)m * 16 + F.lane] = xx > 20.f ? xx : log1pf(__expf(xx)); }
        }
    }
}

__device__ __forceinline__ void rope16(float (&x)[16], const float* cs) {
#pragma unroll
    for (int i = 0; i < 8; ++i) { const float c = cs[2 * i], s = cs[2 * i + 1], a = x[i], b = x[8 + i]; x[i] = a * c - b * s; x[8 + i] = b * c + a * s; }
}
constexpr int KVS = 68;
__device__ __forceinline__ void swa_attend(const float* Ks, const float* Vs, int r0, int jmin, const float (&q)[64], float sink, bf16* dst) {
    float mx = sink, l = 1.0f, o[64];
#pragma unroll
    for (int d = 0; d < 64; ++d) o[d] = 0.f;
#pragma unroll 1
    for (int j = jmin; j < 128; ++j) {
        const float* kr = Ks + (r0 + j) * KVS; float a = 0.f;
#pragma unroll
        for (int d4 = 0; d4 < 16; ++d4) { const f32x4 k4 = *(const f32x4*)(kr + 4 * d4); a += (q[4 * d4] * k4.x + q[4 * d4 + 1] * k4.y) + (q[4 * d4 + 2] * k4.z + q[4 * d4 + 3] * k4.w); }
        if (a > mx) { const float al = __expf(mx - a); mx = a; l *= al;
#pragma unroll
            for (int d = 0; d < 64; ++d) o[d] *= al; }
        const float p = __expf(a - mx); l += p; const float* vr = Vs + (r0 + j) * KVS;
#pragma unroll
        for (int d4 = 0; d4 < 16; ++d4) { const f32x4 v4 = *(const f32x4*)(vr + 4 * d4); o[4 * d4] += p * v4.x; o[4 * d4 + 1] += p * v4.y; o[4 * d4 + 2] += p * v4.z; o[4 * d4 + 3] += p * v4.w; }
    }
    const float il = 1.0f / l;
#pragma unroll
    for (int c = 0; c < 8; ++c) { float f[8];
#pragma unroll
        for (int i = 0; i < 8; ++i) f[i] = o[8 * c + i] * il;
        *(v4u*)(dst + 8 * c) = pack8(f); }
}
__device__ __forceinline__ void p2_phase(Frame& F) {
    const int nthr = F.G * 512, gt = blockIdx.x * 512 + F.tid;
    for (int idx = gt; idx < M * 192; idx += nthr) {
        const int m = idx / 192, ch = (idx % 192) * 8; const bool samp = m >= MP;
        const int b = samp ? (m - MP) >> 2 : m >> 11, t = samp ? (m - MP) & 3 : m & 2047;
        float acc[8];
        { const f32x4 b0 = *(const f32x4*)(F.in[I_CONVB] + ch), b1 = *(const f32x4*)(F.in[I_CONVB] + ch + 4); acc[0] = b0.x; acc[1] = b0.y; acc[2] = b0.z; acc[3] = b0.w; acc[4] = b1.x; acc[5] = b1.y; acc[6] = b1.z; acc[7] = b1.w; }
#pragma unroll
        for (int k = 0; k < 4; ++k) { const int tt = t - 3 + k; float xv[8]; bool have = true;
            if (tt >= 0) { const v4u raw = *(const v4u*)(F.PROJ + (size_t)(m - 3 + k) * NPROJ + C_X + ch); unpack8(raw, xv); }
            else if (samp) { const float* sp = F.in[I_SCONV] + ((size_t)b * 3 + (3 + tt)) * CONVD + ch; const f32x4 a0 = *(const f32x4*)sp, a1 = *(const f32x4*)(sp + 4);
                xv[0] = a0.x; xv[1] = a0.y; xv[2] = a0.z; xv[3] = a0.w; xv[4] = a1.x; xv[5] = a1.y; xv[6] = a1.z; xv[7] = a1.w; }
            else have = false;
            if (have) { const float* wp = F.in[I_CONVW] + (size_t)k * CONVD + ch; const f32x4 w0 = *(const f32x4*)wp, w1 = *(const f32x4*)(wp + 4);
                acc[0] += w0.x * xv[0]; acc[1] += w0.y * xv[1]; acc[2] += w0.z * xv[2]; acc[3] += w0.w * xv[3]; acc[4] += w1.x * xv[4]; acc[5] += w1.y * xv[5]; acc[6] += w1.z * xv[6]; acc[7] += w1.w * xv[7]; } }
#pragma unroll
        for (int i = 0; i < 8; ++i) acc[i] = silu_f(acc[i]);
        *(v4u*)(F.XC + (size_t)m * CONVD + ch) = pack8(acc);
    }
    for (int idx = gt; idx < NBP * 3 * CONVD; idx += nthr) { const int b = idx / (3 * CONVD), i = (idx / CONVD) % 3, ch = idx % CONVD;
        F.out[O_PCONV + idx] = bf2f(F.PROJ[(size_t)(b * SEQ + SEQ - 3 + i) * NPROJ + C_X + ch]); }
    for (int idx = gt; idx < NBS * 3 * CONVD; idx += nthr) { const int b = idx / (3 * CONVD), i = (idx / CONVD) % 3, ch = idx % CONVD;
        F.out[O_SCONV + idx] = bf2f(F.PROJ[(size_t)(MP + 4 * b + 1 + i) * NPROJ + C_X + ch]); }
    float* Ks = (float*)(F.lds + RING_OFF); float* Vs = Ks + 192 * KVS;
    for (int it = blockIdx.x; it < 512; it += F.G) {
        __syncthreads();
        if (it < 256) {
            const int b = it >> 6, tile = (it >> 1) & 31, g = it & 1, t0 = tile * 64;
            for (int ci = F.tid; ci < 192 * 8; ci += 512) { const int r = ci >> 3, c = ci & 7, s = t0 - 127 + r;
                float kv[8], vv[8];
                if (s >= 0 && s < SEQ) { const bf16* pr = F.PROJ + (size_t)(b * SEQ + s) * NPROJ;
                    unpack8(*(const v4u*)(pr + C_V + g * 64 + c * 8), vv);
                    if (c >= 2) unpack8(*(const v4u*)(pr + C_K + g * 64 + c * 8), kv);
                    else if (c == 0) { float x[16], x1[8], x2[8]; unpack8(*(const v4u*)(pr + C_K + g * 64), x1); unpack8(*(const v4u*)(pr + C_K + g * 64 + 8), x2);
#pragma unroll
                        for (int i = 0; i < 8; ++i) { x[i] = x1[i]; x[8 + i] = x2[i]; }
                        rope16(x, F.ROPE + (size_t)s * 16);
#pragma unroll
                        for (int i = 0; i < 8; ++i) { kv[i] = x[i]; *(Ks + r * KVS + 8 + i) = x[8 + i]; } }
                } else {
#pragma unroll
                    for (int i = 0; i < 8; ++i) { kv[i] = 0.f; vv[i] = 0.f; }
                    if (c == 0) {
#pragma unroll
                        for (int i = 0; i < 8; ++i) *(Ks + r * KVS + 8 + i) = 0.f; } }
#pragma unroll
                for (int i = 0; i < 8; ++i) { if (c != 1) Ks[r * KVS + c * 8 + i] = kv[i]; Vs[r * KVS + c * 8 + i] = vv[i]; } }
            __syncthreads();
            if (tile == 31) {
                for (int e = F.tid; e < 128 * 64; e += 512) { const int j = e >> 6, d = e & 63; const size_t o = ((size_t)(b * 128 + j) * 2 + g) * 64 + d;
                    F.out[O_PSK + o] = Ks[(63 + j) * KVS + d]; F.out[O_PSV + o] = Vs[(63 + j) * KVS + d]; } }
            const int tok = F.tid >> 3, head = g * 8 + (F.tid & 7), t = t0 + tok; const size_t m = (size_t)b * SEQ + t;
            float q[64];
#pragma unroll
            for (int c = 0; c < 8; ++c) { float f[8]; unpack8(*(const v4u*)(F.PROJ + m * NPROJ + C_Q + head * 64 + c * 8), f);
#pragma unroll
                for (int i = 0; i < 8; ++i) q[8 * c + i] = f[i]; }
            { float x[16];
#pragma unroll
              for (int i = 0; i < 16; ++i) x[i] = q[i];
              rope16(x, F.ROPE + (size_t)t * 16);
#pragma unroll
              for (int i = 0; i < 16; ++i) q[i] = x[i]; }
#pragma unroll
            for (int d = 0; d < 64; ++d) q[d] *= 0.125f;
            const int jmin = (127 - t) > 0 ? (127 - t) : 0;
            swa_attend(Ks, Vs, tok, jmin, q, F.in[I_SINKS][head], F.YATT + m * DM + 1024 + head * 64);
        } else {
            const int b = (it - 256) >> 1, g = it & 1;
            for (int ci = F.tid; ci < 132 * 8; ci += 512) { const int r = ci >> 3, c = ci & 7;
                float kv[8], vv[8];
                if (r < 128) { const size_t o = ((size_t)(b * 128 + r) * 2 + g) * 64 + c * 8;
                    const f32x4 k0 = *(const f32x4*)(F.in[I_CSK] + o), k1 = *(const f32x4*)(F.in[I_CSK] + o + 4), v0 = *(const f32x4*)(F.in[I_CSV] + o), v1 = *(const f32x4*)(F.in[I_CSV] + o + 4);
                    kv[0] = k0.x; kv[1] = k0.y; kv[2] = k0.z; kv[3] = k0.w; kv[4] = k1.x; kv[5] = k1.y; kv[6] = k1.z; kv[7] = k1.w;
                    vv[0] = v0.x; vv[1] = v0.y; vv[2] = v0.z; vv[3] = v0.w; vv[4] = v1.x; vv[5] = v1.y; vv[6] = v1.z; vv[7] = v1.w;
#pragma unroll
                    for (int i = 0; i < 8; ++i) { Ks[r * KVS + c * 8 + i] = kv[i]; Vs[r * KVS + c * 8 + i] = vv[i]; }
                } else { const int tt = r - 128; const bf16* pr = F.PROJ + (size_t)(MP + 4 * b + tt) * NPROJ;
                    unpack8(*(const v4u*)(pr + C_V + g * 64 + c * 8), vv);
#pragma unroll
                    for (int i = 0; i < 8; ++i) Vs[r * KVS + c * 8 + i] = vv[i];
                    if (c >= 2) { unpack8(*(const v4u*)(pr + C_K + g * 64 + c * 8), kv);
#pragma unroll
                        for (int i = 0; i < 8; ++i) Ks[r * KVS + c * 8 + i] = kv[i]; }
                    else if (c == 0) { float x[16], x1[8], x2[8]; unpack8(*(const v4u*)(pr + C_K + g * 64), x1); unpack8(*(const v4u*)(pr + C_K + g * 64 + 8), x2);
#pragma unroll
                        for (int i = 0; i < 8; ++i) { x[i] = x1[i]; x[8 + i] = x2[i]; }
                        rope16(x, F.ROPE + (size_t)(2048 + tt) * 16);
#pragma unroll
                        for (int i = 0; i < 16; ++i) Ks[r * KVS + i] = x[i]; } } }
            __syncthreads();
            for (int e = F.tid; e < 128 * 64; e += 512) { const int j = e >> 6, d = e & 63; const size_t o = ((size_t)(b * 128 + j) * 2 + g) * 64 + d;
                F.out[O_SSK + o] = Ks[(4 + j) * KVS + d]; F.out[O_SSV + o] = Vs[(4 + j) * KVS + d]; }
            if (F.tid < 32) {
                const int tok = F.tid >> 3, head = g * 8 + (F.tid & 7); const size_t m = (size_t)MP + 4 * b + tok;
                float q[64];
#pragma unroll
                for (int c = 0; c < 8; ++c) { float f[8]; unpack8(*(const v4u*)(F.PROJ + m * NPROJ + C_Q + head * 64 + c * 8), f);
#pragma unroll
                    for (int i = 0; i < 8; ++i) q[8 * c + i] = f[i]; }
                { float x[16];
#pragma unroll
                  for (int i = 0; i < 16; ++i) x[i] = q[i];
                  rope16(x, F.ROPE + (size_t)(2048 + tok) * 16);
#pragma unroll
                  for (int i = 0; i < 16; ++i) q[i] = x[i]; }
#pragma unroll
                for (int d = 0; d < 64; ++d) q[d] *= 0.125f;
                swa_attend(Ks, Vs, tok + 1, 0, q, F.in[I_SINKS][head], F.YATT + m * DM + 1024 + head * 64);
            }
        }
    }
}

template <int NP, int NN>
__device__ __forceinline__ void ssd_seq_item(Frame& F, size_t row0, int T, int head, int p0, const float* h0, float* hout) {
    constexpr int LPP = 128 / NN;
    const int pl = F.tid / LPP, nl = F.tid % LPP, p = p0 + pl, n0 = nl * NN, g = head >> 3;
    float h[NN];
#pragma unroll
    for (int i = 0; i < NN; ++i) h[i] = h0 ? h0[(size_t)p * DST + n0 + i] : 0.f;
    const float a = -__expf(F.in[I_ALOG][head]), Dk = F.in[I_DSKIP][head];
    float* Bs = (float*)(F.lds + RING_OFF); float* Cs = Bs + 64 * 128; float* xs = Cs + 64 * 128; float* zs = xs + 64 * NP; float* dts = zs + 64 * NP; float* decs = dts + 64;
    for (int c0 = 0; c0 < T; c0 += 64) {
        const int nt = (T - c0) < 64 ? (T - c0) : 64;
        __syncthreads();
        for (int it = F.tid; it < nt * 32; it += 512) { const int r = it >> 5, cc = it & 31, which = cc >> 4, c = (cc & 15) * 8; const size_t m = row0 + c0 + r;
            float f[8]; unpack8(*(const v4u*)(F.XC + m * CONVD + (which ? 1280 : 1024) + g * 128 + c), f); float* d = (which ? Cs : Bs) + r * 128 + c;
#pragma unroll
            for (int i = 0; i < 8; ++i) d[i] = f[i]; }
        for (int it = F.tid; it < nt * NP; it += 512) { const int r = it / NP, pp = it % NP; const size_t m = row0 + c0 + r;
            xs[r * NP + pp] = bf2f(F.XC[m * CONVD + head * 64 + p0 + pp]); zs[r * NP + pp] = bf2f(F.PROJ[m * NPROJ + C_Z + head * 64 + p0 + pp]); }
        if (F.tid < nt) { const float dtv = F.DT[(row0 + c0 + F.tid) * 16 + head]; dts[F.tid] = dtv; decs[F.tid] = __expf(dtv * a); }
        __syncthreads();
        for (int t = 0; t < nt; ++t) {
            const float dtv = dts[t], dec = decs[t], xv = xs[t * NP + pl], xdt = xv * dtv; float yp = 0.f;
#pragma unroll
            for (int i4 = 0; i4 < NN / 4; ++i4) { const f32x4 b4 = *(const f32x4*)(Bs + t * 128 + n0 + 4 * i4), c4 = *(const f32x4*)(Cs + t * 128 + n0 + 4 * i4);
                h[4 * i4] = h[4 * i4] * dec + xdt * b4.x; h[4 * i4 + 1] = h[4 * i4 + 1] * dec + xdt * b4.y; h[4 * i4 + 2] = h[4 * i4 + 2] * dec + xdt * b4.z; h[4 * i4 + 3] = h[4 * i4 + 3] * dec + xdt * b4.w;
                yp += (c4.x * h[4 * i4] + c4.y * h[4 * i4 + 1]) + (c4.z * h[4 * i4 + 2] + c4.w * h[4 * i4 + 3]); }
#pragma unroll
            for (int o = 1; o < LPP; o <<= 1) yp += __shfl_xor(yp, o);
            if (nl == 0) { const float z = zs[t * NP + pl]; F.YG[(row0 + c0 + t) * 1024 + head * 64 + p] = (yp + Dk * xv) * silu_f(z); }
        }
    }
#pragma unroll
    for (int i = 0; i < NN; ++i) hout[(size_t)p * DST + n0 + i] = h[i];
}
__device__ __forceinline__ void p3_phase(Frame& F) {
    for (int it = blockIdx.x; it < 256 + 2048; it += F.G) {
        if (it < 256) { const int b = it >> 6, head = (it >> 2) & 15, pq = it & 3;
            ssd_seq_item<16, 4>(F, (size_t)b * SEQ, SEQ, head, pq * 16, nullptr, F.out + O_PSSM + ((size_t)b * NHS + head) * HD * DST);
        } else { const int j = it - 256, b = j >> 4, head = j & 15;
            ssd_seq_item<64, 16>(F, (size_t)MP + 4 * b, TS, head, 0, F.in[I_SSSM] + ((size_t)b * NHS + head) * HD * DST, F.out + O_SSSM + ((size_t)b * NHS + head) * HD * DST); }
    }
}
__device__ __forceinline__ void p4_phase(Frame& F) {
    const int gw = blockIdx.x * NWAVES + F.wave, NGW = F.G * NWAVES;
    for (int it = gw; it < M * 2; it += NGW) { const size_t m = it >> 1; const int g = it & 1;
        const f32x4* yr = (const f32x4*)(F.YG + m * 1024 + g * 512) + F.lane; const f32x4* gr = (const f32x4*)(F.in[I_GNORM] + g * 512) + F.lane;
        const f32x4 a = yr[0], b = yr[64]; float s = (a.x * a.x + a.y * a.y) + (a.z * a.z + a.w * a.w) + (b.x * b.x + b.y * b.y) + (b.z * b.z + b.w * b.w);
        const float rstd = 1.0f / sqrtf(wave_sum(s) * (1.0f / 512.0f) + EPS); const f32x4 ga = gr[0], gb = gr[64];
        unsigned long long* o8 = (unsigned long long*)(F.YATT + m * DM + g * 512) + F.lane;
        o8[0] = (unsigned long long)pk2(a.x * rstd * ga.x, a.y * rstd * ga.y) | ((unsigned long long)pk2(a.z * rstd * ga.z, a.w * rstd * ga.w) << 32);
        o8[64] = (unsigned long long)pk2(b.x * rstd * gb.x, b.y * rstd * gb.y) | ((unsigned long long)pk2(b.z * rstd * gb.z, b.w * rstd * gb.w) << 32);
    }
}
constexpr int XKS = 136, XSS = 257;
__device__ __forceinline__ void p7_phase(Frame& F) {
    bf16* KV = (bf16*)(F.lds + RING_OFF); float* S = (float*)(F.lds + RING_OFF + 256 * XKS * 2);
    for (int it = blockIdx.x; it < 1024 + 512; it += F.G) {
        const bool samp = it >= 1024;
        int b, h, ntok; size_t m0;
        if (!samp) { b = it >> 8; h = (it >> 6) & 3; const int tile = it & 63; m0 = (size_t)b * SEQ + tile * 32; ntok = 32; }
        else { const int j = it - 1024; b = j >> 2; h = j & 3; m0 = (size_t)MP + 4 * b; ntok = 4; }
        for (int pass = 0; pass < 2; ++pass) {
            __syncthreads();
            for (int ci = F.tid; ci < 256 * 16; ci += 512) { const int r = ci >> 4, c = ci & 15; v4u w;
                if (!samp) w = *(const v4u*)(F.MKV + (size_t)(b * NMEM + r) * 1024 + pass * 512 + h * 128 + c * 8);
                else { const float* sp = (pass ? F.in[I_CMV] : F.in[I_CMK]) + ((size_t)(b * NMEM + r) * 4 + h) * 128 + c * 8; const f32x4 a0 = *(const f32x4*)sp, a1 = *(const f32x4*)(sp + 4);
                    w.x = pk2(a0.x, a0.y); w.y = pk2(a0.z, a0.w); w.z = pk2(a1.x, a1.y); w.w = pk2(a1.z, a1.w); }
                *(v4u*)(KV + r * XKS + c * 8) = w; }
            __syncthreads();
            const int tok = F.tid & 31, ck = F.tid >> 5;
            if (pass == 0) {
                if (tok < ntok) {
                    float q[128];
#pragma unroll
                    for (int c = 0; c < 16; ++c) { float f[8]; unpack8(*(const v4u*)(F.QX + (m0 + tok) * XW + h * 128 + c * 8), f);
#pragma unroll
                        for (int i = 0; i < 8; ++i) q[8 * c + i] = f[i]; }
                    for (int kk = 0; kk < 16; ++kk) { const int key = ck * 16 + kk; float a = 0.f;
#pragma unroll
                        for (int c = 0; c < 16; ++c) { float f[8]; unpack8(*(const v4u*)(KV + key * XKS + c * 8), f);
#pragma unroll
                            for (int i = 0; i < 8; ++i) a += q[8 * c + i] * f[i]; }
                        S[tok * XSS + key] = a * 0.08838834764831845f; }
                }
                __syncthreads();
                for (int r = F.wave; r < ntok; r += NWAVES) { float v[4]; float mx = -INFINITY;
#pragma unroll
                    for (int i = 0; i < 4; ++i) { v[i] = S[r * XSS + F.lane + 64 * i]; mx = fmaxf(mx, v[i]); }
#pragma unroll
                    for (int o = 1; o < 64; o <<= 1) mx = fmaxf(mx, __shfl_xor(mx, o));
                    float s = 0.f;
#pragma unroll
                    for (int i = 0; i < 4; ++i) { v[i] = __expf(v[i] - mx); s += v[i]; }
                    s = 1.0f / wave_sum(s);
#pragma unroll
                    for (int i = 0; i < 4; ++i) S[r * XSS + F.lane + 64 * i] = v[i] * s; }
            } else {
                if (tok < ntok) { float o[8];
#pragma unroll
                    for (int i = 0; i < 8; ++i) o[i] = 0.f;
                    for (int key = 0; key < 256; ++key) { const float p = S[tok * XSS + key]; float f[8]; unpack8(*(const v4u*)(KV + key * XKS + ck * 8), f);
#pragma unroll
                        for (int i = 0; i < 8; ++i) o[i] += p * f[i]; }
                    *(v4u*)(F.OX + (m0 + tok) * XW + h * 128 + ck * 8) = pack8(o); }
            }
        }
    }
}
__device__ __forceinline__ void p11_phase(Frame& F) {
    const int gw = blockIdx.x * NWAVES + F.wave, NGW = F.G * NWAVES;
    for (int m = gw; m < M; m += NGW) {
        f32x4* xr = (f32x4*)(F.out + (size_t)m * DM) + F.lane; const f32x4* gr = (const f32x4*)F.in[I_NFINAL] + F.lane;
        f32x4 v[8]; float s = 0.f;
#pragma unroll
        for (int j = 0; j < 8; ++j) { v[j] = xr[64 * j]; s += (v[j].x * v[j].x + v[j].y * v[j].y) + (v[j].z * v[j].z + v[j].w * v[j].w); }
        const float rstd = 1.0f / sqrtf(wave_sum(s) * (1.0f / DM) + EPS);
#pragma unroll
        for (int j = 0; j < 8; ++j) xr[64 * j] = v[j] * rstd * gr[64 * j];
    }
}

struct Args { const float* in[30]; float* out; unsigned char* ws; int ph_lo, ph_hi, li, pad; };
__global__ void __launch_bounds__(NWAVES * 64, 2) hymba_fwd(Args args) {
    extern __shared__ __attribute__((aligned(16))) unsigned char lds[];
    Frame F;
    F.lds = lds; F.ldsl = (LAS unsigned char*)lds;
    F.MISC = (volatile LAS unsigned*)(F.ldsl + MISC_OFF);
    F.tid = threadIdx.x; F.lane = F.tid & 63; F.wave = __builtin_amdgcn_readfirstlane(F.tid >> 6); F.G = gridDim.x;
    unsigned char* ws = args.ws; F.ws = ws; F.out = args.out;
#pragma unroll
    for (int i = 0; i < 30; ++i) F.in[i] = args.in[i];
    F.ctl = (gu32*)(ws + WS_CTL);
    F.Wt_in = (bf16*)(ws + WS_WIN); F.Wt_kv = (bf16*)(ws + WS_WKV); F.Wt_out = (bf16*)(ws + WS_WOUT); F.Wt_xq = (bf16*)(ws + WS_WXQ); F.Wt_xo = (bf16*)(ws + WS_WXO);
    F.Wt_gu = (bf16*)(ws + WS_WGU); F.Wt_dn = (bf16*)(ws + WS_WDN);
    F.XB = (bf16*)(ws + WS_XB); F.MN = (bf16*)(ws + WS_MN); F.MKV = (bf16*)(ws + WS_MKV); F.YATT = (bf16*)(ws + WS_YATT); F.QX = (bf16*)(ws + WS_QX); F.OX = (bf16*)(ws + WS_OX);
    F.PROJ = (bf16*)(ws + WS_PROJ); F.ACT = (bf16*)(ws + WS_ACT); F.XC = (bf16*)(ws + WS_XC);
    F.DT = (float*)(ws + WS_DT); F.ROPE = (float*)(ws + WS_ROPE); F.YG = (float*)(ws + WS_YG);
    F.SSQ1 = (float*)(ws + WS_CTL) + CW_SSQ1; F.SSQ2 = (float*)(ws + WS_CTL) + CW_SSQ2; F.SSQ3 = (float*)(ws + WS_CTL) + CW_SSQ3;
    for (int u = F.tid; u < (LDS_BYTES - LDSCTL_OFF) / 4; u += NWAVES * 64) ((LAS unsigned*)(F.ldsl + LDSCTL_OFF))[u] = 0u;
    __syncthreads();
    XcdBarrier bar; bar.bar = (unsigned*)(F.ctl + CW_BAR); bar.x = 0; bar.st = nullptr;
    if (MK_ONE_LAUNCH) bar = xcd_barrier_post((unsigned*)(F.ctl + CW_BAR), F.MISC + 8);
#define GRID_BAR() do { if (MK_ONE_LAUNCH) xcd_barrier(bar); } while (0)
    const int lo = args.ph_lo, hi = args.ph_hi;
#ifndef PHMASK
#define PHMASK 0xFFF
#endif
#define IN(k) (((PHMASK >> (k)) & 1) && lo <= (k) && (k) < hi)
#define BOTH(k) (IN(k) && IN((k) + 1))
    float* const xres = F.out + O_Y;

    if (IN(0)) { p0_prologue(F); if (BOTH(0)) GRID_BAR(); }
    if (IN(1)) {
        pg8::Gemm g{F.XB, F.Wt_in, M, NPROJ, DM}; pg8::StaticOrder S; S.init(M, NPROJ, F.G, (int)blockIdx.x);
        pg8::EpiBf16S E{F.PROJ, NPROJ, nullptr};
        pg8::gemm_phase<pg8::EpiBf16S, pg8::StaticOrder, PG8_ALIGN, PG8_SP2>(F.ldsl + RING_OFF, g, S, E);
        if (BOTH(1)) GRID_BAR();
    }
    if (IN(2)) { p2_phase(F); if (BOTH(2)) GRID_BAR(); }
    if (IN(3)) { p3_phase(F); if (BOTH(3)) GRID_BAR(); }
    if (IN(4)) { p4_phase(F); if (BOTH(4)) GRID_BAR(); }
    if (IN(5)) {
        pg8::Gemm g{F.YATT, F.Wt_out, M, DM, DM}; pg8::StaticOrder S; S.init(M, DM, F.G, (int)blockIdx.x);
        pg8::EpiResid E{F.in[I_XP], F.in[I_XS], xres, F.XB, F.SSQ1};
        pg8::gemm_phase<pg8::EpiResid, pg8::StaticOrder, PG8_ALIGN, PG8_SP2>(F.ldsl + RING_OFF, g, S, E);
        if (BOTH(5)) GRID_BAR();
    }
    if (IN(6)) {
        { pg8::Gemm g{F.XB, F.Wt_xq, M, XW, DM}; pg8::StaticOrder S; S.init(M, XW, F.G, (int)blockIdx.x);
          pg8::EpiBf16S E{F.QX, XW, F.SSQ1};
          pg8::gemm_phase<pg8::EpiBf16S, pg8::StaticOrder, PG8_ALIGN, PG8_SP2>(F.ldsl + RING_OFF, g, S, E); }
        { pg8::Gemm g{F.MN, F.Wt_kv, MM, 1024, DM}; pg8::StaticOrder S; S.init(MM, 1024, F.G, (int)(F.G - 1 - blockIdx.x));
          pg8::EpiMemKV E{F.out + O_PMK, F.out + O_PMV, F.MKV};
          pg8::gemm_phase<pg8::EpiMemKV, pg8::StaticOrder, PG8_ALIGN, PG8_SP2>(F.ldsl + RING_OFF, g, S, E); }
        if (BOTH(6)) GRID_BAR();
    }
    if (IN(7)) { p7_phase(F); if (BOTH(7)) GRID_BAR(); }
    if (IN(8)) {
        pg8::Gemm g{F.OX, F.Wt_xo, M, DM, XW}; pg8::StaticOrder S; S.init(M, DM, F.G, (int)blockIdx.x);
        pg8::EpiResid E{xres, xres + (size_t)MP * DM, xres, F.XB, F.SSQ2};
        pg8::gemm_phase<pg8::EpiResid, pg8::StaticOrder, PG8_ALIGN, PG8_SP2>(F.ldsl + RING_OFF, g, S, E);
        if (BOTH(8)) GRID_BAR();
    }
    if (IN(9)) {
        pg8::Gemm g{F.XB, F.Wt_gu, M, 2 * DFF, DM}; pg8::StaticOrder S; S.init(M, 2 * DFF, F.G, (int)blockIdx.x);
        pg8::EpiSwiGLU E{F.ACT, DFF, F.SSQ2};
        pg8::gemm_phase<pg8::EpiSwiGLU, pg8::StaticOrder, PG8_ALIGN, PG8_SP2>(F.ldsl + RING_OFF, g, S, E);
        if (BOTH(9)) GRID_BAR();
    }
    if (IN(10)) {
        pg8::Gemm g{F.ACT, F.Wt_dn, M, DM, DFF}; pg8::StaticOrder S; S.init(M, DM, F.G, (int)blockIdx.x);
        pg8::EpiResid E{xres, xres + (size_t)MP * DM, xres, nullptr, F.SSQ3};
        pg8::gemm_phase<pg8::EpiResid, pg8::StaticOrder, PG8_ALIGN, PG8_SP2>(F.ldsl + RING_OFF, g, S, E);
        if (BOTH(10)) GRID_BAR();
    }
    if (IN(11)) { p11_phase(F); }
#undef IN
#undef BOTH
}

extern "C" void kernel_launch(void* const* d_in, const int* in_sizes, int n_in, void* d_out, int out_size, void* d_ws, size_t ws_size, hipStream_t stream) {
    static int grid = 0;
    if (grid == 0) {
        if (n_in != 30 || in_sizes[0] != MP * DM || in_sizes[I_WIN] != DM * IN_DIM || (size_t)out_size != O_END || ws_size < WS_END) {
            fprintf(stderr, "kernel_launch: unexpected shapes: n_in %d in0 %d w_in %d out %d ws %zu; nothing launched\n", n_in, n_in > 0 ? in_sizes[0] : -1, n_in > 10 ? in_sizes[10] : -1, out_size, ws_size); grid = -1; return; }
        int dev = 0, cus = 0, per_cu = 0;
        if (hipGetDevice(&dev) != hipSuccess || hipDeviceGetAttribute(&cus, hipDeviceAttributeMultiprocessorCount, dev) != hipSuccess) { grid = -1; return; }
        if (hipFuncSetAttribute((const void*)hymba_fwd, hipFuncAttributeMaxDynamicSharedMemorySize, LDS_BYTES) != hipSuccess) { fprintf(stderr, "kernel_launch: hipFuncSetAttribute failed\n"); grid = -1; return; }
        if (hipOccupancyMaxActiveBlocksPerMultiprocessor(&per_cu, (const void*)hymba_fwd, NWAVES * 64, LDS_BYTES) != hipSuccess || per_cu < 1) { fprintf(stderr, "kernel_launch: occupancy query says %d blocks per CU\n", per_cu); per_cu = 1; }
        (void)hipGetLastError();
        grid = cus;
    }
    if (grid < 0) return;
    if (hipMemsetAsync((char*)d_ws + WS_CTL, 0, CTL_ZERO_BYTES, stream) != hipSuccess) { fprintf(stderr, "kernel_launch: memset failed\n"); return; }
    Args a{};
    for (int i = 0; i < 30; ++i) a.in[i] = (const float*)d_in[i];
    a.out = (float*)d_out; a.ws = (unsigned char*)d_ws;
    if (MK_ONE_LAUNCH) {
        a.ph_lo = 0; a.ph_hi = NPHASE; a.li = 0;
        hipLaunchKernelGGL(hymba_fwd, dim3(grid), dim3(NWAVES * 64), LDS_BYTES, stream, a);
    } else {
        for (int p = 0; p < NPHASE; ++p) { a.ph_lo = p; a.ph_hi = p + 1; a.li = p; hipLaunchKernelGGL(hymba_fwd, dim3(grid), dim3(NWAVES * 64), LDS_BYTES, stream, a); }
    }
    const hipError_t le = hipPeekAtLastError();
    if (le != hipSuccess) fprintf(stderr, "kernel_launch: launch failed: %s\n", hipGetErrorName(le));
}
```

```cpp
#include <hip/hip_runtime.h>
#include <cstdio>
#include <cstdint>
#include <cmath>
namespace pg8 {
#define PG8_LAS __attribute__((address_space(3)))
typedef unsigned short bf16_t;
typedef short bf16x8 __attribute__((ext_vector_type(8)));
typedef float f32x4 __attribute__((ext_vector_type(4)));
typedef unsigned u32x4 __attribute__((ext_vector_type(4)));
constexpr int BM = 256, BK = 64, HALF = 128, HTB = HALF * BK * 2  , STAGE_BYTES = 8 * HTB, NXCD = 8, WGM = 8;

__host__ __device__ __forceinline__ int lds_byte(int r, int c) { const int st = (r >> 4) * 2 + (c >> 5), rr = r & 15, cc = c & 31, ob = rr * 64 + cc * 2; return st * 1024 + (ob ^ (((ob >> 9) & 1) << 5)); }
__host__ __device__ __forceinline__ void stage_rc(int b, int& R, int& C) { const int st = b / 1024, sb = b % 1024, swz = sb ^ (((sb >> 9) & 1) << 5); R = (st >> 1) * 16 + swz / 64; C = (st & 1) * 32 + (swz % 64) / 2; }
__host__ __device__ __forceinline__ int perm32(int rho) { const int n = rho >> 4, i = rho & 15; return 8 * (i >> 2) + 4 * n + (i & 3); }

struct Unit { int pm, pn, k0, nt, q; };
struct Gemm { const bf16_t* A; const bf16_t* Bt; int M, N, K; };

struct StaticOrder {
    int nM, nN, nwg, G, c;
    __host__ __device__ void init(int M, int N, int G_, int c_) { nM = M / BM; nN = N / BM; nwg = nM * nN; G = G_; c = c_; }
    __host__ __device__ bool next(int i, Unit& u) const {
        const long L = (long)i * G + c; if (L >= nwg) return false;
        int wgid = (int)L; { const int q = nwg / NXCD, r = nwg % NXCD, xcd = wgid % NXCD, off = wgid / NXCD; wgid = (xcd < r ? xcd * (q + 1) : r * (q + 1) + (xcd - r) * q) + off; }
        const int nig = WGM * nN, gid = wgid / nig, fm = gid * WGM, gsz = (nM - fm) < WGM ? (nM - fm) : WGM;
        u.pm = fm + ((wgid % nig) % gsz); u.pn = (wgid % nig) / gsz; u.k0 = 0; u.nt = 0; u.q = -1; return true;
    }
    __device__ __forceinline__ void a_ready(const Unit&) const {}
    __device__ __forceinline__ void done(const Unit&) const {}
};
struct TailOrder : StaticOrder {
    int mode;
    __host__ __device__ bool next(int i, Unit& u) const {
        if (i == 0) return StaticOrder::next(0, u);
        if (i == 1 && c < 128) { const int j = c >> 3, q = c & 7; u.pm = 32 + (j >> 3); u.pn = j & 7; u.q = q;
            if (mode == 0) { u.k0 = q < 4 ? 12 * q : 48 + 10 * (q - 4); u.nt = q < 4 ? 12 : 10; } else { u.k0 = 4 * q; u.nt = 4; }
            return true; }
        return false;
    }
};

typedef float f32x2_t __attribute__((ext_vector_type(2))); typedef __bf16 bf16x2_t __attribute__((ext_vector_type(2)));
__device__ __forceinline__ unsigned cvt_pk_bf16(float lo, float hi) { f32x2_t v = {lo, hi}; bf16x2_t b = __builtin_convertvector(v, bf16x2_t); return __builtin_bit_cast(unsigned, b); }
typedef unsigned u32x2 __attribute__((ext_vector_type(2)));
constexpr float RMS_EPS = 1e-5f;
constexpr int ROWS_P = 8192;
struct EpiBf16S {
    static constexpr bool PERM = true, AFTER_DRAIN = false, KHOOK = false;
    bf16_t* O; int ldc; const float* ssq;
    __device__ __forceinline__ void operator()(const f32x4 (&acc)[2][2][4][2], const Unit& u, int wr, int wc, int fr, int fq) const {
        const int row0 = u.pm * BM + wr * 64 + fr, col0 = u.pn * BM + wc * 32 + 8 * fq;
        float scv[2][4];
        if (ssq) {
#pragma unroll
            for (int ai = 0; ai < 2; ++ai)
#pragma unroll
                for (int m = 0; m < 4; ++m) scv[ai][m] = ssq[row0 + ai * HALF + m * 16];
#pragma unroll
            for (int ai = 0; ai < 2; ++ai)
#pragma unroll
                for (int m = 0; m < 4; ++m) scv[ai][m] = 1.0f / sqrtf(scv[ai][m] * (1.0f / 2048.0f) + RMS_EPS);
        } else {
#pragma unroll
            for (int ai = 0; ai < 2; ++ai)
#pragma unroll
                for (int m = 0; m < 4; ++m) scv[ai][m] = 1.0f; }
#pragma unroll
        for (int ai = 0; ai < 2; ++ai)
#pragma unroll
            for (int m = 0; m < 4; ++m) { const int r = row0 + ai * HALF + m * 16; bf16_t* rowp = O + (size_t)r * ldc + col0;
                const float sc = scv[ai][m];
#pragma unroll
                for (int bj = 0; bj < 2; ++bj) { const f32x4 v0 = acc[ai][bj][m][0] * sc, v1 = acc[ai][bj][m][1] * sc;
                    u32x4 w; w.x = cvt_pk_bf16(v0[0], v0[1]); w.y = cvt_pk_bf16(v0[2], v0[3]); w.z = cvt_pk_bf16(v1[0], v1[1]); w.w = cvt_pk_bf16(v1[2], v1[3]);
                    *(u32x4*)(rowp + bj * HALF) = w; } }
    }
};
struct EpiSwiGLU {
    static constexpr bool PERM = true, AFTER_DRAIN = false, KHOOK = false;
    bf16_t* O; int ldc; const float* ssq;
    __device__ __forceinline__ void operator()(const f32x4 (&acc)[2][2][4][2], const Unit& u, int wr, int wc, int fr, int fq) const {
        const int row0 = u.pm * BM + wr * 64 + fr, col0 = u.pn * 128 + wc * 32 + 8 * fq;
        float scv[2][4];
#pragma unroll
        for (int ai = 0; ai < 2; ++ai)
#pragma unroll
            for (int m = 0; m < 4; ++m) scv[ai][m] = ssq[row0 + ai * HALF + m * 16];
#pragma unroll
        for (int ai = 0; ai < 2; ++ai)
#pragma unroll
            for (int m = 0; m < 4; ++m) { const int r = row0 + ai * HALF + m * 16;
                const float sc = __builtin_amdgcn_rsqf(scv[ai][m] * (1.0f / 2048.0f) + RMS_EPS), c2 = -1.4426950408889634f * sc, s2 = sc * sc;
                f32x4 a[2];
#pragma unroll
                for (int n = 0; n < 2; ++n) { const f32x4 g = acc[ai][0][m][n], up = acc[ai][1][m][n]; const f32x4 t = g * c2; f32x4 d;
#pragma unroll
                    for (int i = 0; i < 4; ++i) d[i] = __builtin_amdgcn_rcpf(1.0f + __builtin_amdgcn_exp2f(t[i]));
                    a[n] = (g * up) * (d * s2); }
                u32x4 w; w.x = cvt_pk_bf16(a[0][0], a[0][1]); w.y = cvt_pk_bf16(a[0][2], a[0][3]); w.z = cvt_pk_bf16(a[1][0], a[1][1]); w.w = cvt_pk_bf16(a[1][2], a[1][3]);
                *(u32x4*)(O + (size_t)r * ldc + col0) = w; }
    }
};
template <bool HOOK> struct EpiResid {
    static constexpr bool PERM = false, AFTER_DRAIN = false, KHOOK = HOOK;
    const float* baseP; const float* baseS; float* out; bf16_t* ob; float* ssq; const float* ssqh; float* slab;
    __device__ __forceinline__ void khook(f32x4 (&acc)[2][2][4][2], const Unit& u, int t, int wr, int wc, int fr, int fq) const {
        const float* bp = ssqh + (size_t)(u.pm * BM + wr * 64 + fr) * 2;
#pragma unroll
        for (int ai = 0; ai < 2; ++ai)
#pragma unroll
            for (int m = 0; m < 4; ++m) { const f32x2_t rg = *(const f32x2_t*)(bp + (ai * HALF + m * 16) * 2); const float r0 = rg[0], r1 = rg[1];
                const float f = (t == 8) ? r0 / r1 : r1;
#pragma unroll
                for (int bj = 0; bj < 2; ++bj)
#pragma unroll
                    for (int n = 0; n < 2; ++n) acc[ai][bj][m][n] = acc[ai][bj][m][n] * f; }
    }
    __device__ __forceinline__ void operator()(const f32x4 (&acc)[2][2][4][2], const Unit& u, int wr, int wc, int fr, int fq) const {
        const int row0 = u.pm * BM + wr * 64 + fr, col0 = u.pn * BM + wc * 32 + 4 * fq;
        if (u.q >= 0) {
            float* sp = slab + ((size_t)u.q * 512 + (row0 - ROWS_P)) * 2048 + col0;
#pragma unroll
            for (int ai = 0; ai < 2; ++ai)
#pragma unroll
                for (int m = 0; m < 4; ++m)
#pragma unroll
                    for (int bj = 0; bj < 2; ++bj)
#pragma unroll
                        for (int n = 0; n < 2; ++n) *(f32x4*)(sp + (size_t)(ai * HALF + m * 16) * 2048 + bj * HALF + n * 16) = acc[ai][bj][m][n];
            return; }
#pragma unroll
        for (int ai = 0; ai < 2; ++ai)
#pragma unroll
            for (int m = 0; m < 4; ++m) { const int r = row0 + ai * HALF + m * 16; const size_t off = (size_t)r * 2048 + col0;
                const float* bp = (r < ROWS_P) ? baseP + off : baseS + (off - (size_t)ROWS_P * 2048);
                float s = 0.f;
#pragma unroll
                for (int bj = 0; bj < 2; ++bj)
#pragma unroll
                    for (int n = 0; n < 2; ++n) { const f32x4 v = acc[ai][bj][m][n] + *(const f32x4*)(bp + bj * HALF + n * 16);
                        *(f32x4*)(out + off + bj * HALF + n * 16) = v; s += (v[0] * v[0] + v[1] * v[1]) + (v[2] * v[2] + v[3] * v[3]);
                        if (ob) { u32x2 w; w.x = cvt_pk_bf16(v[0], v[1]); w.y = cvt_pk_bf16(v[2], v[3]); *(u32x2*)(ob + off + bj * HALF + n * 16) = w; } }
                if (ssq) { s += __shfl_xor(s, 16); s += __shfl_xor(s, 32); if (fq == 0) atomicAdd(ssq + r, s); } }
    }
};
template <bool HOOK, bool F32BASE> struct EpiResidB {
    static constexpr bool PERM = true, AFTER_DRAIN = false, KHOOK = HOOK;
    const float* baseP; const float* baseS; bf16_t* xb; float* ssq; const float* rg; float* slab; bf16_t* xo;
    __device__ __forceinline__ void khook(f32x4 (&acc)[2][2][4][2], const Unit& u, int t, int wr, int wc, int fr, int fq) const {
        const float* bp = rg + (size_t)(u.pm * BM + wr * 64 + fr) * 2;
        f32x2_t g2[2][4];
#pragma unroll
        for (int ai = 0; ai < 2; ++ai)
#pragma unroll
            for (int m = 0; m < 4; ++m) g2[ai][m] = *(const f32x2_t*)(bp + (ai * HALF + m * 16) * 2);
#pragma unroll
        for (int ai = 0; ai < 2; ++ai)
#pragma unroll
            for (int m = 0; m < 4; ++m) { const float f = (t == 8) ? g2[ai][m][0] / g2[ai][m][1] : g2[ai][m][1];
#pragma unroll
                for (int bj = 0; bj < 2; ++bj)
#pragma unroll
                    for (int n = 0; n < 2; ++n) acc[ai][bj][m][n] = acc[ai][bj][m][n] * f; }
    }
    __device__ __forceinline__ void operator()(const f32x4 (&acc)[2][2][4][2], const Unit& u, int wr, int wc, int fr, int fq) const {
        const int row0 = u.pm * BM + wr * 64 + fr, col0 = u.pn * BM + wc * 32 + 8 * fq;
        if (u.q >= 0) {
            float* sp = slab + ((size_t)u.q * 512 + (row0 - ROWS_P)) * 2048 + col0;
            float fv[2][4];
#pragma unroll
            for (int ai = 0; ai < 2; ++ai)
#pragma unroll
                for (int m = 0; m < 4; ++m) fv[ai][m] = (HOOK && u.q < 4) ? rg[(size_t)(row0 + ai * HALF + m * 16) * 2 + (u.q >> 1)] : 1.0f;
#pragma unroll
            for (int ai = 0; ai < 2; ++ai)
#pragma unroll
                for (int m = 0; m < 4; ++m)
#pragma unroll
                    for (int bj = 0; bj < 2; ++bj)
#pragma unroll
                        for (int n = 0; n < 2; ++n) *(f32x4*)(sp + (size_t)(ai * HALF + m * 16) * 2048 + bj * HALF + 4 * n) = acc[ai][bj][m][n] * fv[ai][m];
            return; }
#pragma unroll
        for (int ai = 0; ai < 2; ++ai) {
            f32x4 rb[4][2][2];
            if constexpr (F32BASE) {
#pragma unroll
                for (int m = 0; m < 4; ++m) { const int r = row0 + ai * HALF + m * 16; const size_t off = (size_t)r * 2048 + col0;
                    const float* bp = (r < ROWS_P) ? baseP + off : baseS + (off - (size_t)ROWS_P * 2048);
#pragma unroll
                    for (int bj = 0; bj < 2; ++bj) { rb[m][bj][0] = *(const f32x4*)(bp + bj * HALF); rb[m][bj][1] = *(const f32x4*)(bp + bj * HALF + 4); } }
            } else {
                u32x4 raw[4][2];
#pragma unroll
                for (int m = 0; m < 4; ++m)
#pragma unroll
                    for (int bj = 0; bj < 2; ++bj) raw[m][bj] = *(const u32x4*)(xb + (size_t)(row0 + ai * HALF + m * 16) * 2048 + col0 + bj * HALF);
#pragma unroll
                for (int m = 0; m < 4; ++m)
#pragma unroll
                    for (int bj = 0; bj < 2; ++bj) { const u32x4 q = raw[m][bj];
                        rb[m][bj][0] = (f32x4){__uint_as_float(q.x << 16), __uint_as_float(q.x & 0xffff0000u), __uint_as_float(q.y << 16), __uint_as_float(q.y & 0xffff0000u)};
                        rb[m][bj][1] = (f32x4){__uint_as_float(q.z << 16), __uint_as_float(q.z & 0xffff0000u), __uint_as_float(q.w << 16), __uint_as_float(q.w & 0xffff0000u)}; }
            }
#pragma unroll
            for (int m = 0; m < 4; ++m) { const int r = row0 + ai * HALF + m * 16; const size_t off = (size_t)r * 2048 + col0; float s = 0.f;
#pragma unroll
                for (int bj = 0; bj < 2; ++bj) { const f32x4 v0 = acc[ai][bj][m][0] + rb[m][bj][0], v1 = acc[ai][bj][m][1] + rb[m][bj][1];
                    s += ((v0[0] * v0[0] + v0[1] * v0[1]) + (v0[2] * v0[2] + v0[3] * v0[3])) + ((v1[0] * v1[0] + v1[1] * v1[1]) + (v1[2] * v1[2] + v1[3] * v1[3]));
                    u32x4 w; w.x = cvt_pk_bf16(v0[0], v0[1]); w.y = cvt_pk_bf16(v0[2], v0[3]); w.z = cvt_pk_bf16(v1[0], v1[1]); w.w = cvt_pk_bf16(v1[2], v1[3]);
                    *(u32x4*)(xo + off + bj * HALF) = w; }
                if (ssq) { s += __shfl_xor(s, 16); s += __shfl_xor(s, 32); if (fq == 0) atomicAdd(ssq + r, s); } }
        }
    }
};
struct EpiMemKV {
    static constexpr bool PERM = false, AFTER_DRAIN = false, KHOOK = false;
    float* pmk; float* pmv; bf16_t* ob;
    __device__ __forceinline__ void operator()(const f32x4 (&acc)[2][2][4][2], const Unit& u, int wr, int wc, int fr, int fq) const {
        const int row0 = u.pm * BM + wr * 64 + fr, col0 = u.pn * BM + wc * 32 + 4 * fq, c512 = (u.pn & 1) * BM + wc * 32 + 4 * fq;
        float* dst = (u.pn < 2) ? pmk : pmv;
#pragma unroll
        for (int ai = 0; ai < 2; ++ai)
#pragma unroll
            for (int m = 0; m < 4; ++m) { const int r = row0 + ai * HALF + m * 16;
#pragma unroll
                for (int bj = 0; bj < 2; ++bj)
#pragma unroll
                    for (int n = 0; n < 2; ++n) { const f32x4 v = acc[ai][bj][m][n];
                        *(f32x4*)(dst + (size_t)r * 512 + c512 + bj * HALF + n * 16) = v;
                        u32x2 w; w.x = cvt_pk_bf16(v[0], v[1]); w.y = cvt_pk_bf16(v[2], v[3]); *(u32x2*)(ob + (size_t)r * 1024 + col0 + bj * HALF + n * 16) = w; } }
    }
};

template <class Epi, class Sched, bool ALIGN_EPI = false, bool SP2 = false>
__device__ __forceinline__ void gemm_phase(PG8_LAS unsigned char* lds, const Gemm g, const Sched& S, const Epi& E) {
    const int tid = threadIdx.x, wid = __builtin_amdgcn_readfirstlane(tid >> 6), lane = tid & 63, wr = wid >> 2, wc = wid & 3, fr = lane & 15, fq = lane >> 4;
    const int K = g.K, ntf = K / BK;
    unsigned voffA[2], voffB[2];
#pragma unroll
    for (int i = 0; i < 2; ++i) { int R, C; stage_rc(tid * 16 + i * 8192, R, C); const int Rb = Epi::PERM ? ((R & ~31) + perm32(R & 31)) : R;
        voffA[i] = (unsigned)(R * K + C) * 2u; voffB[i] = (unsigned)(Rb * K + C) * 2u; }
    const size_t kstep = (size_t)(BK * 2);
    const size_t hstep = (size_t)HALF * K * 2;
    const size_t tstep = 2 * hstep;
    const unsigned ldsw = (unsigned)wid * 1024u;
    const int aoff = lds_byte(wr * 64 + fr, fq * 8), boff = lds_byte(wc * 32 + fr, fq * 8);
#define PG8_SA(b, h) (((b) * 2 + (h)) * HTB)
#define PG8_SB(b, h) ((4 + (b) * 2 + (h)) * HTB)
#define PG8_STAGE(bufoff, gbase, voff) do { _Pragma("unroll") for (int _i = 0; _i < 2; ++_i) \
        __builtin_amdgcn_global_load_lds((const unsigned*)((const char*)(gbase) + (voff)[_i]), (PG8_LAS unsigned*)(lds + (bufoff) + ldsw + _i * 8192), 16, 0, 0); } while (0)
#define PG8_LDA(dst, b, h) do { _Pragma("unroll") for (int m = 0; m < 4; ++m) _Pragma("unroll") for (int k = 0; k < 2; ++k) dst[m][k] = *(const PG8_LAS bf16x8*)(lds + PG8_SA(b, h) + aoff + m * 2048 + k * 1024); } while (0)
#define PG8_LDB(dst, b, h) do { _Pragma("unroll") for (int n = 0; n < 2; ++n) _Pragma("unroll") for (int k = 0; k < 2; ++k) dst[n][k] = *(const PG8_LAS bf16x8*)(lds + PG8_SB(b, h) + boff + n * 2048 + k * 1024); } while (0)
#define PG8_MMA(ai, bj, At, Bt) do { __builtin_amdgcn_s_setprio(1); _Pragma("unroll") for (int m = 0; m < 4; ++m) _Pragma("unroll") for (int n = 0; n < 2; ++n) _Pragma("unroll") for (int k = 0; k < 2; ++k) \
        acc[ai][bj][m][n] = __builtin_amdgcn_mfma_f32_16x16x32_bf16(Bt[n][k], At[m][k], acc[ai][bj][m][n], 0, 0, 0); __builtin_amdgcn_s_setprio(0); } while (0)
#define PG8_WAIT_V(n) asm volatile("s_waitcnt vmcnt(" #n ")" ::: "memory")
#define PG8_WAIT_L(n) asm volatile("s_waitcnt lgkmcnt(" #n ")" ::: "memory")
#define PG8_BAR __builtin_amdgcn_s_barrier()
#define PG8_SCHED __builtin_amdgcn_sched_barrier(0)
    Unit cur, nxt; int ui = 0;
    if (!S.next(0, cur)) return;
    f32x4 acc[2][2][4][2];
#pragma unroll
    for (int a = 0; a < 2; ++a)
#pragma unroll
        for (int b = 0; b < 2; ++b)
#pragma unroll
            for (int m = 0; m < 4; ++m)
#pragma unroll
                for (int n = 0; n < 2; ++n) acc[a][b][m][n] = (f32x4){0.f, 0.f, 0.f, 0.f};
    bf16x8 At[4][2], B0[2][2], B1[2][2];
    const char* cA = (const char*)g.A + (size_t)cur.pm * tstep + (size_t)cur.k0 * kstep; const char* cB = (const char*)g.Bt + (size_t)cur.pn * tstep + (size_t)cur.k0 * kstep;
    int nt = cur.nt ? cur.nt : ntf;
    S.a_ready(cur);
    if constexpr (SP2) {
        PG8_STAGE(PG8_SB(0, 0), cB, voffB); PG8_STAGE(PG8_SB(0, 1), cB + hstep, voffB); PG8_STAGE(PG8_SA(0, 0), cA, voffA); PG8_STAGE(PG8_SA(0, 1), cA + hstep, voffA);
        if (wr == 1) PG8_BAR;
        PG8_WAIT_V(2); PG8_BAR;
        PG8_STAGE(PG8_SB(1, 0), cB + kstep, voffB); PG8_STAGE(PG8_SA(1, 0), cA + kstep, voffA); PG8_STAGE(PG8_SB(1, 1), cB + hstep + kstep, voffB);
        PG8_WAIT_V(6); PG8_BAR;
    } else {
        PG8_STAGE(PG8_SB(0, 0), cB, voffB); PG8_STAGE(PG8_SA(0, 0), cA, voffA); PG8_STAGE(PG8_SB(0, 1), cB + hstep, voffB); PG8_STAGE(PG8_SA(0, 1), cA + hstep, voffA);
        if (wr == 1) PG8_BAR;
        PG8_WAIT_V(4); PG8_BAR;
        PG8_STAGE(PG8_SB(1, 0), cB + kstep, voffB); PG8_STAGE(PG8_SA(1, 0), cA + kstep, voffA); PG8_STAGE(PG8_SB(1, 1), cB + hstep + kstep, voffB);
        PG8_WAIT_V(6); PG8_BAR;
    }
    for (;;) {
        const bool has_next = S.next(ui + 1, nxt);
        const char* nA = has_next ? (const char*)g.A + (size_t)nxt.pm * tstep + (size_t)nxt.k0 * kstep : cA; const char* nB = has_next ? (const char*)g.Bt + (size_t)nxt.pn * tstep + (size_t)nxt.k0 * kstep : cB;
        for (int t = 0; t < nt; t += 2) {
            const bool last = (t == nt - 2);
            const char* a1 = cA + (size_t)(t + 1) * kstep;
            const char* a2 = last ? nA : cA + (size_t)(t + 2) * kstep; const char* b2 = last ? nB : cB + (size_t)(t + 2) * kstep;
            const char* a3 = a2 + kstep; const char* b3 = b2 + kstep;
            if (last && has_next) S.a_ready(nxt);
            if constexpr (Epi::KHOOK) { if (t == 8 || t == 16) E.khook(acc, cur, t, wr, wc, fr, fq); }
            if constexpr (SP2) {
            PG8_LDB(B0, 0, 0); PG8_LDB(B1, 0, 1); PG8_SCHED; PG8_LDA(At, 0, 0); PG8_STAGE(PG8_SA(1, 1), a1 + hstep, voffA);
            PG8_WAIT_V(8); PG8_WAIT_L(0); PG8_BAR; PG8_MMA(0, 0, At, B0); PG8_MMA(0, 1, At, B1); PG8_BAR; PG8_SCHED;
            PG8_LDA(At, 0, 1); PG8_STAGE(PG8_SB(0, 0), b2, voffB); PG8_STAGE(PG8_SB(0, 1), b2 + hstep, voffB); PG8_STAGE(PG8_SA(0, 0), a2, voffA);
            PG8_WAIT_V(8); PG8_WAIT_L(0); PG8_BAR; PG8_MMA(1, 0, At, B0); PG8_MMA(1, 1, At, B1); PG8_BAR; PG8_SCHED;
            PG8_LDB(B0, 1, 0); PG8_LDB(B1, 1, 1); PG8_SCHED; PG8_LDA(At, 1, 0); PG8_STAGE(PG8_SA(0, 1), a2 + hstep, voffA);
            PG8_WAIT_V(8); PG8_WAIT_L(0); PG8_BAR; PG8_MMA(0, 0, At, B0); PG8_MMA(0, 1, At, B1); PG8_BAR; PG8_SCHED;
            PG8_LDA(At, 1, 1); PG8_STAGE(PG8_SB(1, 0), b3, voffB); PG8_STAGE(PG8_SB(1, 1), b3 + hstep, voffB); PG8_STAGE(PG8_SA(1, 0), a3, voffA);
            PG8_WAIT_V(8); PG8_WAIT_L(0); PG8_BAR; PG8_MMA(1, 0, At, B0); PG8_MMA(1, 1, At, B1); PG8_BAR; PG8_SCHED;
            } else {
            PG8_LDB(B0, 0, 0); PG8_SCHED; PG8_LDA(At, 0, 0); PG8_STAGE(PG8_SA(1, 1), a1 + hstep, voffA);
            PG8_WAIT_L(8); PG8_BAR; PG8_WAIT_L(0); PG8_MMA(0, 0, At, B0); PG8_BAR; PG8_SCHED;
            PG8_LDB(B1, 0, 1); PG8_STAGE(PG8_SB(0, 0), b2, voffB);
            PG8_BAR; PG8_WAIT_L(0); PG8_MMA(0, 1, At, B1); PG8_BAR;
            PG8_LDA(At, 0, 1); PG8_STAGE(PG8_SA(0, 0), a2, voffA);
            PG8_BAR; PG8_WAIT_L(0); PG8_MMA(1, 0, At, B0); PG8_BAR; PG8_SCHED;
            PG8_STAGE(PG8_SB(0, 1), b2 + hstep, voffB);
            PG8_WAIT_V(6); PG8_BAR; PG8_MMA(1, 1, At, B1); PG8_BAR;
            PG8_LDB(B0, 1, 0); PG8_SCHED; PG8_LDA(At, 1, 0); PG8_STAGE(PG8_SA(0, 1), a2 + hstep, voffA);
            PG8_WAIT_L(8); PG8_BAR; PG8_WAIT_L(0); PG8_MMA(0, 0, At, B0); PG8_BAR; PG8_SCHED;
            PG8_LDB(B1, 1, 1); PG8_STAGE(PG8_SB(1, 0), b3, voffB);
            PG8_BAR; PG8_WAIT_L(0); PG8_MMA(0, 1, At, B1); PG8_BAR;
            PG8_LDA(At, 1, 1); PG8_STAGE(PG8_SA(1, 0), a3, voffA);
            PG8_BAR; PG8_WAIT_L(0); PG8_MMA(1, 0, At, B0); PG8_BAR; PG8_SCHED;
            PG8_STAGE(PG8_SB(1, 1), b3 + hstep, voffB);
            PG8_WAIT_V(6); PG8_BAR; PG8_MMA(1, 1, At, B1); PG8_BAR;
            }
        }
        if constexpr (ALIGN_EPI) { if (wr == 0) PG8_BAR; }
        if constexpr (!Epi::AFTER_DRAIN) { E(acc, cur, wr, wc, fr, fq); S.done(cur); }
        if (!has_next) break;
#pragma unroll
        for (int a = 0; a < 2; ++a)
#pragma unroll
            for (int b = 0; b < 2; ++b)
#pragma unroll
                for (int m = 0; m < 4; ++m)
#pragma unroll
                    for (int n = 0; n < 2; ++n) acc[a][b][m][n] = (f32x4){0.f, 0.f, 0.f, 0.f};
        cur = nxt; cA = nA; cB = nB; ++ui; nt = cur.nt ? cur.nt : ntf;
        if constexpr (ALIGN_EPI) { if (wr == 1) PG8_BAR; }
    }
    PG8_WAIT_V(0);
    if constexpr (!ALIGN_EPI) { if (wr == 0) PG8_BAR; }
    PG8_BAR;
    if constexpr (Epi::AFTER_DRAIN) { E.fused(acc, cur, wr, wc, fr, fq, lds, wid, lane); S.done(cur); }
#undef PG8_SA
#undef PG8_SB
#undef PG8_STAGE
#undef PG8_LDA
#undef PG8_LDB
#undef PG8_MMA
#undef PG8_WAIT_V
#undef PG8_WAIT_L
#undef PG8_BAR
#undef PG8_SCHED
}
}
#ifndef PG8_SP2
#define PG8_SP2 true
#endif
#ifndef PG8_ALIGN
#define PG8_ALIGN true
#endif
constexpr int NWAVES = 8;
#ifndef MK_ONE_LAUNCH
#define MK_ONE_LAUNCH 1
#endif
constexpr int NPHASE = 13;

constexpr int DM = 2048, SEQ = 2048, NBP = 4, NBS = 128, TS = 4;
constexpr int MP = NBP * SEQ, MS = NBS * TS, M = MP + MS;
constexpr int NMEM = 256, MM = NBP * NMEM;
constexpr int IN_DIM = 3856, NPROJ = 3840;
constexpr int C_Z = 0, C_X = 1024, C_B = 2048, C_C = 2304, C_Q = 2560, C_K = 3584, C_V = 3712;
constexpr int W_DT = 2560;
constexpr int CONVD = 1536, XW = 512, DFF = 5632, NHS = 16, HD = 64, DST = 128, WIN = 128;
constexpr float EPS = 1e-5f;
constexpr int PAST = 16384;
constexpr size_t O_Y = 0, O_PSSM = 17825792, O_PCONV = 18350080, O_PSK = 18368512, O_PSV = 18434048, O_PMK = 18499584, O_PMV = 19023872,
                 O_SSSM = 19548160, O_SCONV = 36325376, O_SSK = 36915200, O_SSV = 39012352, O_END = 41109504;

constexpr size_t MiB = 1u << 20;
constexpr size_t WS_CTL = 0, CTL_ZERO_BYTES = 1 * MiB;
constexpr size_t WS_DT = 1 * MiB;
constexpr size_t WS_ROPE = 2 * MiB;
constexpr size_t WS_CS = 3 * MiB, WS_CD = 3 * MiB + 512 * 1024, WS_SSQH = 4 * MiB;
constexpr size_t WS_WIN = 8 * MiB, WS_WKV = 23 * MiB, WS_WOUT = 27 * MiB, WS_WXQ = 35 * MiB, WS_WXO = 37 * MiB, WS_WGU = 39 * MiB, WS_WDN = 83 * MiB;
constexpr size_t WS_XB = 105 * MiB;
constexpr size_t WS_SLAB = 145 * MiB;
constexpr size_t WS_MN = 139 * MiB;
constexpr size_t WS_MKV = 143 * MiB;
constexpr size_t WS_YATT = 145 * MiB;
constexpr size_t WS_QX = 179 * MiB, WS_OX = 188 * MiB;
constexpr size_t WS_PROJ = 197 * MiB;
constexpr size_t WS_ACT = 197 * MiB;
constexpr size_t WS_HSB = 261 * MiB;
constexpr size_t WS_ST = 291 * MiB;
constexpr size_t WS_XC = 326 * MiB;
constexpr size_t WS_END = 352 * MiB;
constexpr int CW_TMO = 0, CW_CODE = 1;
constexpr int CW_BAR = 4096;
constexpr int CW_SSQ1 = 16384, CW_SSQ2 = CW_SSQ1 + 8704, CW_SSQ3 = CW_SSQ2 + 8704;
static_assert((CW_SSQ3 + 8704) * 4 <= (int)CTL_ZERO_BYTES, "CTL words inside the memset region");

constexpr int RING_OFF = 0, RING_BYTES = 131072;
constexpr int LDS_BYTES = 163840;
constexpr int LDSCTL_OFF = LDS_BYTES - 1024, MISC_OFF = LDSCTL_OFF + 320;
static_assert(MISC_OFF + 128 <= LDS_BYTES, "LDS map");

#define GAS __attribute__((address_space(1)))
#define LAS __attribute__((address_space(3)))
typedef unsigned short bf16;
typedef unsigned v4u __attribute__((ext_vector_type(4)));
typedef float f32x4 __attribute__((ext_vector_type(4)));
typedef short bf16x8 __attribute__((ext_vector_type(8)));
typedef GAS unsigned gu32;
typedef GAS unsigned long long gu64;
#define RLX_AGENT __ATOMIC_RELAXED, __HIP_MEMORY_SCOPE_AGENT
#define LDS_WAIT() asm volatile("s_waitcnt lgkmcnt(0)" ::: "memory")
#define VM_WAIT() asm volatile("s_waitcnt vmcnt(0)" ::: "memory")
__device__ __forceinline__ unsigned long long rt() { return __builtin_amdgcn_s_memrealtime(); }
__device__ __forceinline__ unsigned f2bf(float f) { unsigned u = __builtin_bit_cast(unsigned, f); return (u + 0x7fffu + ((u >> 16) & 1u)) >> 16; }
__device__ __forceinline__ unsigned pk2(float lo, float hi) { return f2bf(lo) | (f2bf(hi) << 16); }

#define XB_TMO      128
#define XB_XCNT(j)  (256  + 64 * (j))
#define XB_XSUB(j)  (1280 + 64 * (j))
#define XB_XGEN(j)  (2304 + 64 * (j))
#define XB_TOP      3328
#define XB_TOPGEN   3392
#define XCD_BAR_WORDS 3456
#define XB_SPIN_CAP (1u << 18)

__device__ __forceinline__ unsigned xb_ld(unsigned* p)              { return __hip_atomic_load(p, __ATOMIC_RELAXED, __HIP_MEMORY_SCOPE_AGENT); }
__device__ __forceinline__ unsigned xb_add(unsigned* p, unsigned v) { return __hip_atomic_fetch_add(p, v, __ATOMIC_RELAXED, __HIP_MEMORY_SCOPE_AGENT); }
__device__ __forceinline__ unsigned xb_xcc_id() { return (unsigned)__builtin_amdgcn_s_getreg((3 << 11) | 20) & 0xFu; }
#define XB_SPIN(cond, bar) do { unsigned _sp = 0; while (cond) { __builtin_amdgcn_s_sleep(1); \
    if ((++_sp & 255u) == 0u) { if (xb_ld(&(bar)[XB_TMO])) break; if (_sp > XB_SPIN_CAP) { atomicAdd(&(bar)[XB_TMO], 1u); break; } } } } while (0)

struct XcdBarrier {
    unsigned* bar; unsigned x;
    volatile LAS unsigned* st;
};

__device__ __forceinline__ XcdBarrier xcd_barrier_post(unsigned* bar, volatile LAS unsigned* st) {
    XcdBarrier b; b.bar = bar; b.x = xb_xcc_id(); b.st = st;
    if (threadIdx.x == 0) (void)xb_add(&bar[XB_XCNT(b.x)], 1u);
    return b;
}
__device__ __forceinline__ void xcd_barrier_complete(unsigned* bar, unsigned x, unsigned& nloc, unsigned& nx) {
    const unsigned G = gridDim.x * gridDim.y * gridDim.z;
    unsigned sum, cnt, mine, sp = 0u;
    for (;;) {
        sum = 0u; cnt = 0u; mine = 0u;
#pragma unroll
        for (unsigned j = 0; j < 16; ++j) { const unsigned c = xb_ld(&bar[XB_XCNT(j)]); sum += c; cnt += (c > 0u) ? 1u : 0u; mine = (j == x) ? c : mine; }
        if (sum == G) break;
        __builtin_amdgcn_s_sleep(1);
        if ((++sp & 255u) == 0u) { if (xb_ld(&bar[XB_TMO])) break; if (sp > XB_SPIN_CAP) { atomicAdd(&bar[XB_TMO], 1u); break; } }
    }
    nloc = mine > 0u ? mine : 1u; nx = cnt > 0u ? cnt : 1u;
}

__device__ __forceinline__ void xcd_barrier(const XcdBarrier& b) {
    asm volatile("s_waitcnt vmcnt(0)" ::: "memory");
    __syncthreads();
    if (threadIdx.x == 0) {
        unsigned* bar = b.bar;
        __builtin_amdgcn_s_waitcnt(0);
        unsigned nloc = b.st[0], nx = b.st[1];
        if (nloc == 0u) { xcd_barrier_complete(bar, b.x, nloc, nx); b.st[0] = nloc; b.st[1] = nx; }
        const unsigned old = xb_add(&bar[XB_XSUB(b.x)], 1u);
        const unsigned gen = old / nloc;
        if (old + 1u == (gen + 1u) * nloc) {
            __builtin_amdgcn_fence(__ATOMIC_RELEASE, "agent");
            asm volatile("s_waitcnt vmcnt(0)" ::: "memory");
            const unsigned og = xb_add(&bar[XB_TOP], 1u);
            const unsigned tg = og / nx;
            if (og + 1u == (tg + 1u) * nx) xb_add(&bar[XB_TOPGEN], 1u);
            else XB_SPIN(xb_ld(&bar[XB_TOPGEN]) == tg, bar);
            __builtin_amdgcn_fence(__ATOMIC_ACQUIRE, "agent");
            xb_add(&bar[XB_XGEN(b.x)], 1u);
            asm volatile("s_waitcnt vmcnt(0)" ::: "memory");
        } else {
            XB_SPIN(xb_ld(&bar[XB_XGEN(b.x)]) == gen, bar);
            __builtin_amdgcn_fence(__ATOMIC_ACQUIRE, "agent");
            asm volatile("s_waitcnt vmcnt(0)" ::: "memory");
        }
    }
    __syncthreads();
}
struct Frame {
    unsigned char* lds;
    LAS unsigned char* ldsl;
    volatile LAS unsigned* MISC;
    gu32* ctl;
    int tid, lane, wave, G, vcu;
    const float* in[30]; float* out; unsigned char* ws;
    __device__ __forceinline__ bf16* Wt_in() const { return (bf16*)(ws + WS_WIN); }
    __device__ __forceinline__ bf16* Wt_kv() const { return (bf16*)(ws + WS_WKV); }
    __device__ __forceinline__ bf16* Wt_out() const { return (bf16*)(ws + WS_WOUT); }
    __device__ __forceinline__ bf16* Wt_xq() const { return (bf16*)(ws + WS_WXQ); }
    __device__ __forceinline__ bf16* Wt_xo() const { return (bf16*)(ws + WS_WXO); }
    __device__ __forceinline__ bf16* Wt_gu() const { return (bf16*)(ws + WS_WGU); }
    __device__ __forceinline__ bf16* Wt_dn() const { return (bf16*)(ws + WS_WDN); }
    __device__ __forceinline__ bf16* XB() const { return (bf16*)(ws + WS_XB); }
    __device__ __forceinline__ bf16* MN() const { return (bf16*)(ws + WS_MN); }
    __device__ __forceinline__ bf16* MKV() const { return (bf16*)(ws + WS_MKV); }
    __device__ __forceinline__ bf16* YATT() const { return (bf16*)(ws + WS_YATT); }
    __device__ __forceinline__ bf16* QX() const { return (bf16*)(ws + WS_QX); }
    __device__ __forceinline__ bf16* OX() const { return (bf16*)(ws + WS_OX); }
    __device__ __forceinline__ bf16* PROJ() const { return (bf16*)(ws + WS_PROJ); }
    __device__ __forceinline__ bf16* ACT() const { return (bf16*)(ws + WS_ACT); }
    __device__ __forceinline__ bf16* XC() const { return (bf16*)(ws + WS_XC); }
    __device__ __forceinline__ bf16* XCT() const { return (bf16*)(ws + WS_XB); }
    __device__ __forceinline__ bf16* HSb() const { return (bf16*)(ws + WS_HSB); }
    __device__ __forceinline__ float* DT() const { return (float*)(ws + WS_DT); }
    __device__ __forceinline__ float* ROPE() const { return (float*)(ws + WS_ROPE); }
    __device__ __forceinline__ float* CS() const { return (float*)(ws + WS_CS); }
    __device__ __forceinline__ float* CD() const { return (float*)(ws + WS_CD); }
    __device__ __forceinline__ float* RG() const { return (float*)(ws + WS_SSQH); }
    __device__ __forceinline__ float* ST() const { return (float*)(ws + WS_ST); }
    __device__ __forceinline__ float* SSQ1() const { return (float*)(ws + WS_CTL) + CW_SSQ1; }
    __device__ __forceinline__ float* SSQ2() const { return (float*)(ws + WS_CTL) + CW_SSQ2; }
    __device__ __forceinline__ float* SSQ3() const { return (float*)(ws + WS_CTL) + CW_SSQ3; }
};
enum { I_XP = 0, I_XS, I_MEM, I_SSSM, I_SCONV, I_CSK, I_CSV, I_CMK, I_CMV, I_NMIX, I_WIN, I_CONVW, I_CONVB, I_DTB, I_ALOG, I_DSKIP, I_GNORM, I_SINKS,
       I_WOUT, I_NMEM, I_NX, I_WXQ, I_WXK, I_WXV, I_WXO, I_NFFN, I_WGATE, I_WUP, I_WDOWN, I_NFINAL };

template <class T> __device__ __forceinline__ T ldnt(const T* p) { return __builtin_nontemporal_load(p); }
template <class T> __device__ __forceinline__ void stnt(T* p, T v) { __builtin_nontemporal_store(v, p); }
__device__ __forceinline__ float bf2f(unsigned u16) { return __uint_as_float(u16 << 16); }
__device__ __forceinline__ void unpack8(const v4u& v, float (&f)[8]) {
    f[0] = __uint_as_float(v.x << 16); f[1] = __uint_as_float(v.x & 0xffff0000u); f[2] = __uint_as_float(v.y << 16); f[3] = __uint_as_float(v.y & 0xffff0000u);
    f[4] = __uint_as_float(v.z << 16); f[5] = __uint_as_float(v.z & 0xffff0000u); f[6] = __uint_as_float(v.w << 16); f[7] = __uint_as_float(v.w & 0xffff0000u);
}
__device__ __forceinline__ v4u pack8(const float (&f)[8]) { v4u o; o.x = pk2(f[0], f[1]); o.y = pk2(f[2], f[3]); o.z = pk2(f[4], f[5]); o.w = pk2(f[6], f[7]); return o; }
__device__ __forceinline__ float wave_sum(float v) {
#pragma unroll
    for (int o = 1; o < 64; o <<= 1) v += __shfl_xor(v, o);
    return v;
}
__device__ __forceinline__ float silu_f(float x) { return x / (1.0f + __expf(-x)); }

typedef float f32x2p __attribute__((ext_vector_type(2))); typedef unsigned u32x2p __attribute__((ext_vector_type(2)));
#define LO2(v) __builtin_shufflevector((v), (v), 0, 1)
#define HI2(v) __builtin_shufflevector((v), (v), 2, 3)
#define FMA2(x, y, z) __builtin_elementwise_fma((x), (y), (z))
__device__ __forceinline__ void p0_transpose_item(const float* W, int ldw, int col0, int K, int N, bf16* WT, int mode, int rowoff, const float* ks, int kslim, float* scr, int item, int lane) {
    const int nblk = N / 64, kb = item / nblk, nb = item % nblk, k0 = 64 * kb, n0 = 64 * nb;
    const int n4 = lane & 15, kr = lane >> 4;
    f32x4 v[16];
#pragma unroll
    for (int i = 0; i < 16; ++i) { const int kk = 4 * i + kr; v[i] = ldnt((const f32x4*)(W + (size_t)(k0 + kk) * ldw + col0 + n0 + 4 * n4)); }
    float kv[16];
    if (ks) {
#pragma unroll
        for (int i = 0; i < 16; ++i) { const int k = k0 + 4 * i + kr; kv[i] = ks[k < kslim ? k : 0]; }
#pragma unroll
        for (int i = 0; i < 16; ++i) { const int k = k0 + 4 * i + kr; kv[i] = (k < kslim) ? kv[i] : 1.0f; }
    } else {
#pragma unroll
        for (int i = 0; i < 16; ++i) kv[i] = 1.0f; }
#pragma unroll
    for (int i = 0; i < 16; ++i) { const int kk = 4 * i + kr; *(f32x4*)(scr + kk * 64 + 4 * (n4 ^ ((kk >> 3) & 7))) = v[i] * kv[i]; }
    LDS_WAIT(); asm volatile("" ::: "memory");
    const int c = lane & 7;
#pragma unroll
    for (int j = 0; j < 8; ++j) { const int n = (lane >> 3) + 8 * j; const float* s = scr + (8 * c) * 64 + (n ^ (4 * c)); const int nn = n0 + n;
        const int drow = (mode == 0) ? rowoff + nn : 256 * (nn >> 7) + (nn & 127) + rowoff;
        v4u o; o.x = pg8::cvt_pk_bf16(s[0 * 64], s[1 * 64]); o.y = pg8::cvt_pk_bf16(s[2 * 64], s[3 * 64]); o.z = pg8::cvt_pk_bf16(s[4 * 64], s[5 * 64]); o.w = pg8::cvt_pk_bf16(s[6 * 64], s[7 * 64]);
        *(v4u*)(WT + (size_t)drow * K + k0 + 8 * c) = o; }
    LDS_WAIT(); asm volatile("" ::: "memory");
}
__device__ __forceinline__ void p0_prologue(Frame& F, int parts = 7) {
    const int gw = blockIdx.x * NWAVES + F.wave, NGW = F.G * NWAVES;
    float* scr = (float*)(F.lds + RING_OFF + F.wave * 16384);
    constexpr int I0 = 32 * 40, I1 = 32 * 20, I2 = 256, I3 = 256, I4 = 1024, I5 = 256, I6 = 256, I7 = 2816, I8 = 2816, I9 = 2816;
    constexpr int NITEMS = I0 + I1 + I2 + I3 + I4 + I5 + I6;
    if (parts & 1) for (int it = gw; it < NITEMS; it += NGW) {
        int r = it;
        if (r < I0) { p0_transpose_item(F.in[I_WIN], IN_DIM, 0, DM, 2560, F.Wt_in(), 0, 0, nullptr, 0, scr, r, F.lane); continue; } r -= I0;
        if (r < I1) { p0_transpose_item(F.in[I_WIN], IN_DIM, 2576, DM, 1280, F.Wt_in(), 0, 2560, nullptr, 0, scr, r, F.lane); continue; } r -= I1;
        if (r < I2) { p0_transpose_item(F.in[I_WXK], XW, 0, DM, XW, F.Wt_kv(), 0, 0, nullptr, 0, scr, r, F.lane); continue; } r -= I2;
        if (r < I3) { p0_transpose_item(F.in[I_WXV], XW, 0, DM, XW, F.Wt_kv(), 0, 512, nullptr, 0, scr, r, F.lane); continue; } r -= I3;
        if (r < I4) { p0_transpose_item(F.in[I_WOUT], DM, 0, DM, DM, F.Wt_out(), 0, 0, F.in[I_GNORM], 1024, scr, r, F.lane); continue; } r -= I4;
        if (r < I5) { p0_transpose_item(F.in[I_WXQ], XW, 0, DM, XW, F.Wt_xq(), 0, 0, F.in[I_NX], 1 << 30, scr, r, F.lane); continue; } r -= I5;
        p0_transpose_item(F.in[I_WXO], DM, 0, XW, DM, F.Wt_xo(), 0, 0, nullptr, 0, scr, r, F.lane);
    }
    const bool g256 = (F.G == 256);
    if (parts & 2) for (int e = (g256 ? ((int)blockIdx.x >= 161 ? (int)blockIdx.x - 161 : (int)blockIdx.x + 95) : (int)blockIdx.x) * 512 + F.tid; e < 2052 * 8; e += F.G * 512) {
        const int idx = e >> 3, i = e & 7; const double pos = (double)(idx < 2048 ? idx : PAST + idx - 2048);
        const double ang = pos * pow(500000.0, -(double)i / 8.0);
        F.ROPE()[2 * e] = (float)cos(ang); F.ROPE()[2 * e + 1] = (float)sin(ang);
    }
    __syncthreads();
    float* wdt = (float*)(F.lds + RING_OFF);
#pragma unroll 16
    for (int e = F.tid; e < 4 * DM; e += 512) { const int k = e >> 2, q = e & 3; const f32x4 w4 = *(const f32x4*)(F.in[I_WIN] + (size_t)k * IN_DIM + W_DT + 4 * q);
        wdt[(4 * q) * DM + k] = w4.x; wdt[(4 * q + 1) * DM + k] = w4.y; wdt[(4 * q + 2) * DM + k] = w4.z; wdt[(4 * q + 3) * DM + k] = w4.w; }
    float* gL = wdt + 16 * DM;
    for (int e = F.tid; e < 2 * DM / 4; e += 512) ((f32x4*)gL)[e] = (e < DM / 4) ? ((const f32x4*)F.in[I_NMIX])[e] : ((const f32x4*)F.in[I_NMEM])[e - DM / 4];
    __syncthreads();
    constexpr int NPAIR = (M + MM) / 2;
    const int third = 2 * NGW + ((int)blockIdx.x - 65) * NWAVES + F.wave;
    const bool has3 = g256 && (int)blockIdx.x >= 65 && third < NPAIR;
    const int npair = (parts & 4) ? (g256 ? (has3 ? 3 : 2) : (NPAIR - gw + NGW - 1) / NGW) : 0;
#define P0_PIDX(i_) ((g256 && (i_) == 2) ? third : gw + (i_) * NGW)
#define P0_ROWPTR(pr_) ((2 * (pr_)) >= M ? F.in[I_MEM] + (size_t)(2 * (pr_) - M) * DM : ((2 * (pr_)) < MP ? F.in[I_XP] + (size_t)(2 * (pr_)) * DM : F.in[I_XS] + (size_t)(2 * (pr_) - MP) * DM))
#define P0_LOAD(pr_, a_, b_) do { const f32x4* xr_ = (const f32x4*)(P0_ROWPTR(pr_)) + F.lane; _Pragma("unroll") for (int j = 0; j < 8; ++j) { a_[j] = ldnt(xr_ + 64 * j); b_[j] = ldnt(xr_ + 512 + 64 * j); } } while (0)
    f32x4 a[8], b[8];
    if (npair > 0) P0_LOAD(P0_PIDX(0), a, b);
#pragma unroll 1
    for (int i = 0; i < npair; ++i) {
        const int pr = P0_PIDX(i), m = 2 * pr; const bool ismem = m >= M, more = (i + 1) < npair;
        f32x4 na[8], nb[8];
        { const int pn = more ? P0_PIDX(i + 1) : pr; P0_LOAD(pn, na, nb); }
        const LAS f32x4* gr = (const LAS f32x4*)(F.ldsl + RING_OFF + (16 + (ismem ? 1 : 0)) * DM * 4) + F.lane;
        f32x2p q0 = {0.f, 0.f}, q1 = {0.f, 0.f};
#pragma unroll
        for (int j = 0; j < 8; ++j) { q0 = FMA2(LO2(a[j]), LO2(a[j]), q0); q0 = FMA2(HI2(a[j]), HI2(a[j]), q0); q1 = FMA2(LO2(b[j]), LO2(b[j]), q1); q1 = FMA2(HI2(b[j]), HI2(b[j]), q1); }
        const float r0 = 1.0f / sqrtf(wave_sum(q0.x + q0.y) * (1.0f / DM) + EPS), r1 = 1.0f / sqrtf(wave_sum(q1.x + q1.y) * (1.0f / DM) + EPS);
#pragma unroll
        for (int j = 0; j < 8; ++j) { const f32x4 g = gr[64 * j]; a[j] = a[j] * (g * r0); b[j] = b[j] * (g * r1); }
        bf16* orow = ismem ? F.MN() + (size_t)(m - M) * DM : F.XB() + (size_t)m * DM;
        u32x2p* o8 = (u32x2p*)orow + F.lane;
#pragma unroll
        for (int j = 0; j < 8; ++j) { u32x2p wa, wb; wa.x = pg8::cvt_pk_bf16(a[j].x, a[j].y); wa.y = pg8::cvt_pk_bf16(a[j].z, a[j].w); wb.x = pg8::cvt_pk_bf16(b[j].x, b[j].y); wb.y = pg8::cvt_pk_bf16(b[j].z, b[j].w);
                                      o8[64 * j] = wa; o8[512 + 64 * j] = wb; }
        if (!ismem && !(parts & 8)) {
            float P[32];
            unsigned wo = 16u * F.lane; asm volatile("" : "+v"(wo));
            const LAS float* wl = (const LAS float*)(F.ldsl + RING_OFF + wo);
#pragma unroll
            for (int h = 0; h < 16; ++h) { f32x2p c0 = {0.f, 0.f}, c1 = {0.f, 0.f};
#pragma unroll
                for (int j = 0; j < 8; ++j) { const f32x4 w = *(const LAS f32x4*)(wl + h * DM + 256 * j);
                    c0 = FMA2(LO2(a[j]), LO2(w), c0); c1 = FMA2(LO2(b[j]), LO2(w), c1); c0 = FMA2(HI2(a[j]), HI2(w), c0); c1 = FMA2(HI2(b[j]), HI2(w), c1); }
                P[h] = c0.x + c0.y; P[16 + h] = c1.x + c1.y; if (h & 1) __builtin_amdgcn_sched_barrier(0); }
#pragma unroll
            for (int st = 0; st < 5; ++st) { const int half = 16 >> st; const bool up = (F.lane >> st) & 1;
#pragma unroll
                for (int q = 0; q < 16; ++q) if (q < half) { float x = P[q], y = P[q + half]; asm volatile("" : "+v"(x), "+v"(y));
                    const float keep = up ? y : x, send = up ? x : y; P[q] = keep + __shfl_xor(send, 1 << st); } }
            const float tot = P[0] + __shfl_xor(P[0], 32);
            if (F.lane < 32) { const int l = F.lane, rr = l & 1, h = (((l >> 1) & 1) << 3) | (((l >> 2) & 1) << 2) | (((l >> 3) & 1) << 1) | ((l >> 4) & 1);
                const float xx = tot + F.in[I_DTB][h]; F.DT()[(size_t)(m + rr) * 16 + h] = xx > 20.f ? xx : log1pf(__expf(xx)); }
        }
#pragma unroll
        for (int j = 0; j < 8; ++j) { a[j] = na[j]; b[j] = nb[j]; }
    }
#undef P0_PIDX
#undef P0_ROWPTR
#undef P0_LOAD
}


__device__ __forceinline__ void ffn_weight_copies(Frame& F, int which, int cu0, int cu1) {
    if ((int)blockIdx.x < cu0 || (int)blockIdx.x >= cu1) return;
    const int gw = ((int)blockIdx.x - cu0) * NWAVES + F.wave, NGW = (cu1 - cu0) * NWAVES;
    float* scr = (float*)(F.lds + RING_OFF + F.wave * 16384);
    if (which == 0) { for (int it = gw; it < 2 * 2816; it += NGW) { if (it < 2816) p0_transpose_item(F.in[I_WGATE], DFF, 0, DM, DFF, F.Wt_gu(), 1, 0, F.in[I_NFFN], 1 << 30, scr, it, F.lane);
                                                                   else p0_transpose_item(F.in[I_WUP], DFF, 0, DM, DFF, F.Wt_gu(), 1, 128, F.in[I_NFFN], 1 << 30, scr, it - 2816, F.lane); } }
    else { for (int it = gw; it < 2816; it += NGW) p0_transpose_item(F.in[I_WDOWN], DM, 0, DFF, DM, F.Wt_dn(), 0, 0, nullptr, 0, scr, it, F.lane); }
}
typedef float f32x16 __attribute__((ext_vector_type(16)));
typedef unsigned u32x2v __attribute__((ext_vector_type(2)));
typedef unsigned u32x4 __attribute__((ext_vector_type(4)));
#define MFMA32(a, b, c) __builtin_amdgcn_mfma_f32_32x32x16_bf16((a), (b), (c), 0, 0, 0)
__device__ __forceinline__ v4u pack8c(const float (&f)[8]) { v4u o; o.x = pg8::cvt_pk_bf16(f[0], f[1]); o.y = pg8::cvt_pk_bf16(f[2], f[3]); o.z = pg8::cvt_pk_bf16(f[4], f[5]); o.w = pg8::cvt_pk_bf16(f[6], f[7]); return o; }
constexpr int LP = 136;

template <bool SAMP>
__device__ __forceinline__ void conv_loop(Frame& F) {
    bf16* T = (bf16*)(F.lds + RING_OFF); constexpr int TP = 136;
    const int quad = F.tid >> 4, c8 = F.tid & 15;
    constexpr int IT0 = SAMP ? 64 * 12 : 0, IT1 = SAMP ? 68 * 12 : 64 * 12;
#define CONV_LOAD(it_, raw_) do { const int m_ = ((it_) / 12) * 128 + 4 * quad, ch_ = ((it_) % 12) * 128 + c8 * 8; const bool has_ = !SAMP && ((m_ & 2047) > 0); \
        _Pragma("unroll") for (int j = 0; j < 7; ++j) raw_[j] = *(const v4u*)(F.PROJ() + (size_t)((j >= 3 || has_) ? m_ - 3 + j : m_) * NPROJ + C_X + ch_); } while (0)
    int it = IT0 + blockIdx.x; v4u cur[7], nxt[7];
    if (it < IT1) CONV_LOAD(it, cur);
#pragma unroll 1
    for (; it < IT1; it += F.G) {
        const int tb = it / 12, cb = it % 12, m0 = tb * 128, ch0 = cb * 128, ch = ch0 + c8 * 8; const bool tr = !SAMP && (ch0 < 1280);
        const int m = m0 + 4 * quad; const int t = SAMP ? 0 : (m & 2047);
        f32x4 wv[5][2], sv[3][2];
        { const float* bp_ = F.in[I_CONVB] + ch; wv[4][0] = *(const f32x4*)bp_; wv[4][1] = *(const f32x4*)(bp_ + 4);
#pragma unroll
          for (int k = 0; k < 4; ++k) { const float* wp = F.in[I_CONVW] + (size_t)k * CONVD + ch; wv[k][0] = *(const f32x4*)wp; wv[k][1] = *(const f32x4*)(wp + 4); }
          if constexpr (SAMP) {
#pragma unroll
              for (int j = 0; j < 3; ++j) { const float* sp = F.in[I_SCONV] + ((size_t)((m - MP) >> 2) * 3 + j) * CONVD + ch; sv[j][0] = *(const f32x4*)sp; sv[j][1] = *(const f32x4*)(sp + 4); } } }
        __builtin_amdgcn_sched_barrier(0);
        { const int itn = (it + F.G < IT1) ? it + F.G : it; CONV_LOAD(itn, nxt); }
        __builtin_amdgcn_sched_barrier(0);
        float r[7][8];
#pragma unroll
        for (int j = 0; j < 7; ++j) {
            if (j >= 3) unpack8(cur[j], r[j]);
            else if constexpr (SAMP) { r[j][0] = sv[j][0].x; r[j][1] = sv[j][0].y; r[j][2] = sv[j][0].z; r[j][3] = sv[j][0].w; r[j][4] = sv[j][1].x; r[j][5] = sv[j][1].y; r[j][6] = sv[j][1].z; r[j][7] = sv[j][1].w; }
            else { unpack8(cur[j], r[j]);
#pragma unroll
                for (int e = 0; e < 8; ++e) r[j][e] = (t > 0) ? r[j][e] : 0.f; } }
        float o[4][8];
        { const f32x4 b0 = wv[4][0], b1 = wv[4][1];
#pragma unroll
          for (int i = 0; i < 4; ++i) { o[i][0] = b0.x; o[i][1] = b0.y; o[i][2] = b0.z; o[i][3] = b0.w; o[i][4] = b1.x; o[i][5] = b1.y; o[i][6] = b1.z; o[i][7] = b1.w; } }
#pragma unroll
        for (int k = 0; k < 4; ++k) { const f32x4 w0 = wv[k][0], w1 = wv[k][1];
            const float w[8] = {w0.x, w0.y, w0.z, w0.w, w1.x, w1.y, w1.z, w1.w};
#pragma unroll
            for (int i = 0; i < 4; ++i)
#pragma unroll
                for (int e = 0; e < 8; ++e) o[i][e] += w[e] * r[i + k][e]; }
#pragma unroll
        for (int i = 0; i < 4; ++i)
#pragma unroll
            for (int e = 0; e < 8; ++e) o[i][e] = silu_f(o[i][e]);
        if (SAMP || ch0 >= 1024) {
#pragma unroll
            for (int i = 0; i < 4; ++i) *(v4u*)(F.XC() + (size_t)(m + i) * CONVD + ch) = pack8c(o[i]); }
        __syncthreads();
        if (tr) {
#pragma unroll
            for (int e = 0; e < 8; ++e) { u32x2v w; w.x = pg8::cvt_pk_bf16(o[0][e], o[1][e]); w.y = pg8::cvt_pk_bf16(o[2][e], o[3][e]); *(u32x2v*)(T + (c8 * 8 + e) * TP + 4 * quad) = w; }
            __syncthreads();
#pragma unroll
            for (int j = 0; j < 4; ++j) { const int idx = F.tid + 512 * j, chl = idx >> 4, t16 = idx & 15;
                *(v4u*)(F.XCT() + (size_t)(ch0 + chl) * MP + m0 + t16 * 8) = *(const v4u*)(T + chl * TP + t16 * 8); } }
#pragma unroll
        for (int j = 0; j < 7; ++j) cur[j] = nxt[j];
    }
#undef CONV_LOAD
}
__device__ __forceinline__ void conv_phase(Frame& F) { conv_loop<false>(F); conv_loop<true>(F); }

__device__ __forceinline__ void ssd_s1_item(Frame& F, int b, int c, int g, int pb) {
    const int m0 = b * SEQ + c * 128, w = F.wave, head = 8 * g + w, lane = F.lane, r = lane & 31, h = lane >> 5;
    bf16* BT = (bf16*)(F.lds + RING_OFF);
    float* wL = (float*)(F.lds + RING_OFF + 128 * LP * 2);
    __syncthreads();
#pragma unroll
    for (int i = 0; i < 4; ++i) { const int idx = F.tid + 512 * i, n = idx >> 4, c16 = idx & 15;
        *(v4u*)(BT + n * LP + c16 * 8) = *(const v4u*)(F.XCT() + (size_t)(1024 + g * 128 + n) * MP + m0 + c16 * 8); }
    const float a = -__expf(F.in[I_ALOG][head]);
    const float dt0 = F.DT()[(size_t)(m0 + lane) * 16 + head], dt1 = F.DT()[(size_t)(m0 + 64 + lane) * 16 + head];
    float p0 = dt0 * a, p1 = dt1 * a;
#pragma unroll
    for (int o = 1; o < 64; o <<= 1) { const float t0 = __shfl_up(p0, o), t1 = __shfl_up(p1, o); if (lane >= o) { p0 += t0; p1 += t1; } }
    p1 += __shfl(p0, 63); const float cend = __shfl(p1, 63);
    if (pb == 0) { F.CS()[(size_t)(m0 + lane) * 16 + head] = p0; F.CS()[(size_t)(m0 + 64 + lane) * 16 + head] = p1; if (lane == 0) F.CD()[(b * 16 + head) * 16 + c] = __expf(cend); }
    wL[w * 128 + lane] = __expf(cend - p0) * dt0; wL[w * 128 + 64 + lane] = __expf(cend - p1) * dt1;
    __syncthreads();
    f32x16 acc[4];
#pragma unroll
    for (int nb = 0; nb < 4; ++nb)
#pragma unroll
        for (int i = 0; i < 16; ++i) acc[nb][i] = 0.f;
    const bf16* xrow = F.XCT() + (size_t)(head * 64 + 32 * pb + r) * MP + m0 + 8 * h;
#pragma unroll
    for (int ks = 0; ks < 8; ++ks) {
        const f32x4 w0 = *(const f32x4*)(wL + w * 128 + 16 * ks + 8 * h), w1 = *(const f32x4*)(wL + w * 128 + 16 * ks + 8 * h + 4);
        float f[8]; unpack8(*(const v4u*)(xrow + 16 * ks), f);
        f[0] *= w0.x; f[1] *= w0.y; f[2] *= w0.z; f[3] *= w0.w; f[4] *= w1.x; f[5] *= w1.y; f[6] *= w1.z; f[7] *= w1.w;
        const bf16x8 A = __builtin_bit_cast(bf16x8, pack8c(f));
#pragma unroll
        for (int nb = 0; nb < 4; ++nb) { const bf16x8 Bf = *(const bf16x8*)(BT + (32 * nb + r) * LP + 16 * ks + 8 * h); acc[nb] = MFMA32(A, Bf, acc[nb]); }
    }
    bf16* st = (bf16*)F.ST() + ((size_t)(b * 16 + head) * 16 + c) * 8192;
#pragma unroll
    for (int nb = 0; nb < 4; ++nb)
#pragma unroll
        for (int i = 0; i < 16; ++i) st[(32 * pb + (i & 3) + 8 * (i >> 2) + 4 * h) * 128 + 32 * nb + r] = (bf16)(pg8::cvt_pk_bf16(acc[nb][i], 0.f) & 0xffffu);
}

__device__ __forceinline__ void ssd_s2_phase(Frame& F) {
    for (int tg = blockIdx.x * 512 + F.tid; tg < 64 * 2048; tg += F.G * 512) {
        const int bh = tg >> 11, e4 = tg & 2047; const bf16* base = (const bf16*)F.ST() + (size_t)bh * 16 * 8192 + 4 * e4;
        u32x2v q[16]; float d[16];
#pragma unroll
        for (int c = 0; c < 16; ++c) q[c] = *(const u32x2v*)(base + (size_t)c * 8192);
#pragma unroll
        for (int c = 0; c < 16; ++c) d[c] = F.CD()[bh * 16 + c];
        __builtin_amdgcn_sched_barrier(0);
        f32x4 hh = {0.f, 0.f, 0.f, 0.f};
#pragma unroll
        for (int c = 0; c < 16; ++c) { u32x2v o; o.x = pg8::cvt_pk_bf16(hh.x, hh.y); o.y = pg8::cvt_pk_bf16(hh.z, hh.w);
            *(u32x2v*)(F.HSb() + ((size_t)bh * 16 + c) * 8192 + 4 * e4) = o;
            const f32x4 sc = {__uint_as_float(q[c].x << 16), __uint_as_float(q[c].x & 0xffff0000u), __uint_as_float(q[c].y << 16), __uint_as_float(q[c].y & 0xffff0000u)};
            hh = hh * d[c] + sc; }
        *(f32x4*)(F.out + O_PSSM + (size_t)bh * 8192 + 4 * e4) = hh;
    }
}

__device__ __forceinline__ void ssd_sample_item(Frame& F, int b, int head, float* ssqL) {
    const int lane = F.lane, pl = lane >> 3, nl = lane & 7, n0 = 4 * nl, g = head >> 3;
    const float a = -__expf(F.in[I_ALOG][head]), Dk = F.in[I_DSKIP][head];
    const float* h0 = F.in[I_SSSM] + (size_t)(b * 16 + head) * 8192; float* ho = F.out + O_SSSM + (size_t)(b * 16 + head) * 8192;
    float dtv[4], dec[4]; u32x2v Bp[4][4], Cp[4][4]; bf16 xr[4], zr[4];
    float* xzL = ssqL + 64 + F.wave * 512;
#pragma unroll
    for (int t = 0; t < 4; ++t) { const size_t m = (size_t)MP + 4 * b + t; dtv[t] = F.DT()[m * 16 + head];
        const bf16* br = F.XC() + m * CONVD + 1024 + g * 128 + n0; const bf16* cr = F.XC() + m * CONVD + 1280 + g * 128 + n0;
#pragma unroll
        for (int i = 0; i < 4; ++i) { Bp[t][i] = *(const u32x2v*)(br + 32 * i); Cp[t][i] = *(const u32x2v*)(cr + 32 * i); }
        xr[t] = F.XC()[m * CONVD + head * 64 + lane]; zr[t] = F.PROJ()[m * NPROJ + C_Z + head * 64 + lane]; }
    __builtin_amdgcn_sched_barrier(0);
    f32x4 sa[4], sb[4], sc[4];
#pragma unroll
    for (int i = 0; i < 4; ++i) { sa[i] = ldnt((const f32x4*)(h0 + (size_t)(pl) * 128 + n0 + 32 * i)); sb[i] = ldnt((const f32x4*)(h0 + (size_t)(8 + pl) * 128 + n0 + 32 * i)); sc[i] = ldnt((const f32x4*)(h0 + (size_t)(16 + pl) * 128 + n0 + 32 * i)); }
    __builtin_amdgcn_sched_barrier(0);
#pragma unroll
    for (int t = 0; t < 4; ++t) { xzL[t * 64 + lane] = bf2f(xr[t]); xzL[256 + t * 64 + lane] = bf2f(zr[t]); }
#pragma unroll
    for (int t = 0; t < 4; ++t) dec[t] = __expf(dtv[t] * a);
    asm volatile("s_waitcnt lgkmcnt(0)" ::: "memory"); __builtin_amdgcn_wave_barrier();
    float ssq[4] = {0.f, 0.f, 0.f, 0.f};
#pragma unroll 1
    for (int pass = 0; pass < 8; ++pass) {
        const int p = 8 * pass + pl; float hh[16];
#pragma unroll
        for (int i = 0; i < 4; ++i) { hh[4 * i] = sa[i].x; hh[4 * i + 1] = sa[i].y; hh[4 * i + 2] = sa[i].z; hh[4 * i + 3] = sa[i].w; sa[i] = sb[i]; sb[i] = sc[i]; }
        { const bool on = pass < 5; const float* src = on ? h0 + (size_t)(p + 24) * 128 + n0 : h0; const int st = on ? 32 : 0;
#pragma unroll
          for (int i = 0; i < 4; ++i) sc[i] = ldnt((const f32x4*)(src + st * i)); }
#pragma unroll
        for (int t = 0; t < 4; ++t) { const size_t m = (size_t)MP + 4 * b + t;
            const float xv = xzL[t * 64 + p], z = xzL[256 + t * 64 + p], xdt = xv * dtv[t];
            asm volatile("" : "+v"(Bp[t][0]), "+v"(Bp[t][1]), "+v"(Bp[t][2]), "+v"(Bp[t][3]), "+v"(Cp[t][0]), "+v"(Cp[t][1]), "+v"(Cp[t][2]), "+v"(Cp[t][3]));
            float yp = 0.f;
#pragma unroll
            for (int i = 0; i < 4; ++i) { const u32x2v bq = Bp[t][i], cq = Cp[t][i];
                const float b0 = __uint_as_float(bq.x << 16), b1 = __uint_as_float(bq.x & 0xffff0000u), b2 = __uint_as_float(bq.y << 16), b3 = __uint_as_float(bq.y & 0xffff0000u);
                const float c0 = __uint_as_float(cq.x << 16), c1 = __uint_as_float(cq.x & 0xffff0000u), c2 = __uint_as_float(cq.y << 16), c3 = __uint_as_float(cq.y & 0xffff0000u);
                hh[4 * i] = hh[4 * i] * dec[t] + xdt * b0; hh[4 * i + 1] = hh[4 * i + 1] * dec[t] + xdt * b1; hh[4 * i + 2] = hh[4 * i + 2] * dec[t] + xdt * b2; hh[4 * i + 3] = hh[4 * i + 3] * dec[t] + xdt * b3;
                yp += (c0 * hh[4 * i] + c1 * hh[4 * i + 1]) + (c2 * hh[4 * i + 2] + c3 * hh[4 * i + 3]); }
            yp += __shfl_xor(yp, 1); yp += __shfl_xor(yp, 2); yp += __shfl_xor(yp, 4);
            const float v = (yp + Dk * xv) * silu_f(z);
            if (nl == 0) { F.YATT()[m * DM + head * 64 + p] = (bf16)f2bf(v); ssq[t] += v * v; }
        }
#pragma unroll
        for (int i = 0; i < 4; ++i) { f32x4 v; v.x = hh[4 * i]; v.y = hh[4 * i + 1]; v.z = hh[4 * i + 2]; v.w = hh[4 * i + 3]; stnt((f32x4*)(ho + (size_t)p * 128 + n0 + 32 * i), v); }
    }
#pragma unroll
    for (int t = 0; t < 4; ++t) { float s = ssq[t]; s += __shfl_xor(s, 8); s += __shfl_xor(s, 16); s += __shfl_xor(s, 32); if (lane == 0) ssqL[F.wave * 4 + t] = s; }
}

template <int TB>
__device__ __forceinline__ void s3_wfrags(const bf16* Bn, const bf16* Cn, const float* csw, const float* dtw, int lane, bf16x8 (&Cf)[8], bf16x8 (&Wf)[TB + 1][2]) {
    const int r = lane & 31, h = lane >> 5, t = 32 * TB + r; const float cs_t = csw[t];
#pragma unroll
    for (int ks = 0; ks < 8; ++ks) Cf[ks] = *(const bf16x8*)(Cn + t * LP + 16 * ks + 8 * h);
#pragma unroll
    for (int sb = 0; sb <= TB; ++sb) {
        f32x16 X;
#pragma unroll
        for (int i = 0; i < 16; ++i) X[i] = 0.f;
#pragma unroll
        for (int ks = 0; ks < 8; ++ks) { const bf16x8 A = *(const bf16x8*)(Bn + (32 * sb + r) * LP + 16 * ks + 8 * h); X = MFMA32(A, Cf[ks], X); }
        float e[16];
#pragma unroll
        for (int g4 = 0; g4 < 4; ++g4) { const int s0 = 32 * sb + 8 * g4 + 4 * h; const f32x4 cs4 = *(const f32x4*)(csw + s0), dt4 = *(const f32x4*)(dtw + s0);
#pragma unroll
            for (int k = 0; k < 4; ++k) { const float ev = __expf(cs_t - cs4[k]) * dt4[k]; e[4 * g4 + k] = (sb < TB || (s0 + k) <= t) ? X[4 * g4 + k] * ev : 0.f; } }
        u32x4 w0, w1;
        w0.x = pg8::cvt_pk_bf16(e[0], e[1]); w0.y = pg8::cvt_pk_bf16(e[2], e[3]); w0.z = pg8::cvt_pk_bf16(e[4], e[5]); w0.w = pg8::cvt_pk_bf16(e[6], e[7]);
        w1.x = pg8::cvt_pk_bf16(e[8], e[9]); w1.y = pg8::cvt_pk_bf16(e[10], e[11]); w1.z = pg8::cvt_pk_bf16(e[12], e[13]); w1.w = pg8::cvt_pk_bf16(e[14], e[15]);
        Wf[sb][0] = __builtin_bit_cast(bf16x8, w0); Wf[sb][1] = __builtin_bit_cast(bf16x8, w1);
    }
}
template <int TB>
__device__ __forceinline__ void s3_ymma(const bf16* XT, const bf16x8 (&Wf)[TB + 1][2], int lane, f32x16& y, unsigned (&xs)[8]) {
    const int r = lane & 31, h = lane >> 5, t = 32 * TB + r;
#pragma unroll
    for (int i = 0; i < 16; ++i) y[i] = 0.f;
    const bf16* xr = XT + r * LP + 4 * h;
#pragma unroll
    for (int sb = 0; sb <= TB; ++sb)
#pragma unroll
        for (int s2 = 0; s2 < 2; ++s2) { const u32x2v lo = *(const u32x2v*)(xr + 32 * sb + 16 * s2), hi = *(const u32x2v*)(xr + 32 * sb + 16 * s2 + 8);
            u32x4 av; av.x = lo.x; av.y = lo.y; av.z = hi.x; av.w = hi.y; y = MFMA32(__builtin_bit_cast(bf16x8, av), Wf[sb][s2], y); }
#pragma unroll
    for (int i = 0; i < 4; ++i)
#pragma unroll
        for (int k = 0; k < 2; ++k) xs[2 * i + k] = (unsigned)XT[(8 * i + 4 * h + 2 * k) * LP + t] | ((unsigned)XT[(8 * i + 4 * h + 2 * k + 1) * LP + t] << 16);
}
template <int TB>
__device__ __forceinline__ void s3_fin(Frame& F, const bf16* HT, const bf16* Cn, const f32x16& y, const unsigned (&xs)[8], float ecs, const u32x2v (&zg)[4], size_t m, int head, int pb, float Dk, float& ssq) {
    const int lane = F.lane, r = lane & 31, h = lane >> 5, t = 32 * TB + r;
    f32x16 yo;
#pragma unroll
    for (int i = 0; i < 16; ++i) yo[i] = 0.f;
    const bf16* hr = HT + r * LP + 8 * h;
#pragma unroll
    for (int ks = 0; ks < 8; ++ks) { const bf16x8 A = *(const bf16x8*)(hr + 16 * ks), Cfk = *(const bf16x8*)(Cn + t * LP + 16 * ks + 8 * h); yo = MFMA32(A, Cfk, yo); }
#pragma unroll
    for (int i = 0; i < 4; ++i) { const int p0 = 32 * pb + 8 * i + 4 * h; const u32x2v zq = zg[i];
        const float z0 = __uint_as_float(zq.x << 16), z1 = __uint_as_float(zq.x & 0xffff0000u), z2 = __uint_as_float(zq.y << 16), z3 = __uint_as_float(zq.y & 0xffff0000u);
        const float x0 = __uint_as_float(xs[2 * i] << 16), x1 = __uint_as_float(xs[2 * i] & 0xffff0000u), x2 = __uint_as_float(xs[2 * i + 1] << 16), x3 = __uint_as_float(xs[2 * i + 1] & 0xffff0000u);
        const float v0 = (y[4 * i] + ecs * yo[4 * i] + Dk * x0) * silu_f(z0), v1 = (y[4 * i + 1] + ecs * yo[4 * i + 1] + Dk * x1) * silu_f(z1);
        const float v2 = (y[4 * i + 2] + ecs * yo[4 * i + 2] + Dk * x2) * silu_f(z2), v3 = (y[4 * i + 3] + ecs * yo[4 * i + 3] + Dk * x3) * silu_f(z3);
        ssq += (v0 * v0 + v1 * v1) + (v2 * v2 + v3 * v3);
        u32x2v o; o.x = pg8::cvt_pk_bf16(v0, v1); o.y = pg8::cvt_pk_bf16(v2, v3);
        *(u32x2v*)(F.YATT() + m * DM + head * 64 + p0) = o; }
}
template <int TA, int TBB>
__device__ __forceinline__ void ssd_s3_body(Frame& F, const bf16* Bn, const bf16* Cn, const float* csw, const float* dtw, float* ssqL, bf16* WB, int m0, int head, const bf16* hs) {
    const int lane = F.lane, r = lane & 31, h = lane >> 5, w = F.wave;
    bf16x8 Wfa[TA + 1][2], Wfb[TBB + 1][2];
    { bf16x8 Cf[8]; s3_wfrags<TA>(Bn, Cn, csw, dtw, lane, Cf, Wfa); } __builtin_amdgcn_sched_barrier(0);
    { bf16x8 Cf[8]; s3_wfrags<TBB>(Bn, Cn, csw, dtw, lane, Cf, Wfb); } __builtin_amdgcn_sched_barrier(0);
    const float ecsa = __expf(csw[32 * TA + r]), ecsb = __expf(csw[32 * TBB + r]), Dk = F.in[I_DSKIP][head];
    const size_t ma = (size_t)m0 + 32 * TA + r, mb = (size_t)m0 + 32 * TBB + r;
    float ssqa = 0.f, ssqb = 0.f;
#pragma unroll 1
    for (int pb = 0; pb < 2; ++pb) {
        v4u xg[8], hg[8]; u32x2v zga[4], zgb[4];
        { const bf16* src = F.XCT() + (size_t)(head * 64 + 32 * pb) * MP + m0; const bf16* hsrc = hs + (size_t)(32 * pb) * 128;
#pragma unroll
          for (int j = 0; j < 8; ++j) { const int row = (lane >> 4) + 4 * j, ch = lane & 15; xg[j] = *(const v4u*)(src + (size_t)row * MP + 8 * ch); hg[j] = *(const v4u*)(hsrc + row * 128 + 8 * ch); }
#pragma unroll
          for (int i = 0; i < 4; ++i) { zga[i] = *(const u32x2v*)(F.PROJ() + ma * NPROJ + C_Z + head * 64 + 32 * pb + 8 * i + 4 * h); zgb[i] = *(const u32x2v*)(F.PROJ() + mb * NPROJ + C_Z + head * 64 + 32 * pb + 8 * i + 4 * h); } }
        asm volatile("s_waitcnt lgkmcnt(0)" ::: "memory"); __builtin_amdgcn_wave_barrier();
#pragma unroll
        for (int j = 0; j < 8; ++j) { const int row = (lane >> 4) + 4 * j, ch = lane & 15; *(v4u*)(WB + row * LP + 8 * ch) = xg[j]; }
        asm volatile("s_waitcnt lgkmcnt(0)" ::: "memory"); __builtin_amdgcn_wave_barrier();
        f32x16 ya, yb; unsigned xsa[8], xsb[8];
        s3_ymma<TA>(WB, Wfa, lane, ya, xsa); __builtin_amdgcn_sched_barrier(0);
        s3_ymma<TBB>(WB, Wfb, lane, yb, xsb); __builtin_amdgcn_sched_barrier(0);
        asm volatile("s_waitcnt lgkmcnt(0)" ::: "memory"); __builtin_amdgcn_wave_barrier();
#pragma unroll
        for (int j = 0; j < 8; ++j) { const int row = (lane >> 4) + 4 * j, ch = lane & 15; *(v4u*)(WB + row * LP + 8 * ch) = hg[j]; }
        asm volatile("s_waitcnt lgkmcnt(0)" ::: "memory"); __builtin_amdgcn_wave_barrier();
        s3_fin<TA>(F, WB, Cn, ya, xsa, ecsa, zga, ma, head, pb, Dk, ssqa); __builtin_amdgcn_sched_barrier(0);
        s3_fin<TBB>(F, WB, Cn, yb, xsb, ecsb, zgb, mb, head, pb, Dk, ssqb); __builtin_amdgcn_sched_barrier(0);
    }
    ssqa += __shfl_xor(ssqa, 32); ssqb += __shfl_xor(ssqb, 32);
    if (h == 0) { ssqL[w * 64 + r] = ssqa; ssqL[w * 64 + 32 + r] = ssqb; }
    __syncthreads();
    if (F.tid < 64) { float s = 0.f;
#pragma unroll
        for (int q = 0; q < 8; ++q) s += ssqL[q * 64 + F.tid];
        const int tt = (F.tid < 32) ? 32 * TA + F.tid : 32 * TBB + (F.tid - 32);
        F.RG()[((size_t)m0 + tt) * 2 + (head >> 3)] = 1.0f / sqrtf(s * (1.0f / 512.0f) + EPS); }
}
__device__ __forceinline__ void ssd_s3_item(Frame& F, int b, int c, int g, int th) {
    const int m0 = b * SEQ + c * 128, w = F.wave, head = 8 * g + w, lane = F.lane;
    bf16* Bn = (bf16*)(F.lds + RING_OFF); bf16* Cn = Bn + 128 * LP; float* csL = (float*)(F.lds + RING_OFF + 2 * 128 * LP * 2); float* dtL = csL + 8 * 128; float* ssqL = dtL + 8 * 128;
    bf16* WB = (bf16*)(F.lds + RING_OFF + 2 * 128 * LP * 2 + 10240) + (size_t)w * 32 * LP;
    __syncthreads();
#pragma unroll
    for (int i = 0; i < 8; ++i) { const int idx = F.tid + 512 * i, which = idx >> 11, rem = idx & 2047, s = rem >> 4, c16 = rem & 15;
        *(v4u*)((which ? Cn : Bn) + s * LP + c16 * 8) = *(const v4u*)(F.XC() + (size_t)(m0 + s) * CONVD + (which ? 1280 : 1024) + g * 128 + c16 * 8); }
    float* csw = csL + w * 128; float* dtw = dtL + w * 128;
    csw[lane] = F.CS()[(size_t)(m0 + lane) * 16 + head]; csw[64 + lane] = F.CS()[(size_t)(m0 + 64 + lane) * 16 + head];
    dtw[lane] = F.DT()[(size_t)(m0 + lane) * 16 + head]; dtw[64 + lane] = F.DT()[(size_t)(m0 + 64 + lane) * 16 + head];
    __syncthreads();
    const bf16* hs = F.HSb() + ((size_t)(b * 16 + head) * 16 + c) * 8192;
    if (th == 0) ssd_s3_body<0, 3>(F, Bn, Cn, csw, dtw, ssqL, WB, m0, head, hs);
    else ssd_s3_body<1, 2>(F, Bn, Cn, csw, dtw, ssqL, WB, m0, head, hs);
}
__device__ __forceinline__ void ssd_p3_phase(Frame& F) {
    for (int it = F.vcu; it < 256; it += F.G) ssd_s1_item(F, it >> 6, (it >> 2) & 15, (it >> 1) & 1, it & 1);
}
__device__ __forceinline__ void ssd_p4_phase(Frame& F) {
    ssd_s2_phase(F);
    float* ssqL = (float*)(F.lds + RING_OFF);
    for (int it = blockIdx.x; it < NBS * 2; it += F.G) { const int b = it >> 1, g = it & 1;
        __syncthreads();
        ssd_sample_item(F, b, 8 * g + F.wave, ssqL);
        __syncthreads();
        if (F.tid < 4) { float s = 0.f;
#pragma unroll
            for (int q = 0; q < 8; ++q) s += ssqL[q * 4 + F.tid];
            F.RG()[((size_t)MP + 4 * b + F.tid) * 2 + g] = 1.0f / sqrtf(s * (1.0f / 512.0f) + EPS); } }
}
__device__ __forceinline__ void ssd_p5_phase(Frame& F) {
    for (int it = F.vcu; it < 256; it += F.G) ssd_s3_item(F, it >> 6, (it >> 2) & 15, (it >> 1) & 1, it & 1);
}
constexpr float LOG2E = 1.4426950408889634f;
template <int NKB, int NKS, int NDB, class MaskF>
__device__ __forceinline__ void attn_chunk(const bf16* Kt, int KP, const bf16* VT, int VP, int key0, const bf16x8 (&q)[NKS], float scale2, MaskF mask, float& mx, float& l, f32x16 (&o)[NDB], int lane) {
    const int r = lane & 31, h = lane >> 5;
    f32x16 S[NKB];
#pragma unroll
    for (int kb = 0; kb < NKB; ++kb) {
#pragma unroll
        for (int i = 0; i < 16; ++i) S[kb][i] = 0.f;
#pragma unroll
        for (int ks = 0; ks < NKS; ++ks) { const bf16x8 A = *(const bf16x8*)(Kt + (key0 + 32 * kb + r) * KP + 16 * ks + 8 * h); S[kb] = MFMA32(A, q[ks], S[kb]); }
        __builtin_amdgcn_sched_barrier(0);
    }
    float cmax = -INFINITY;
#pragma unroll
    for (int kb = 0; kb < NKB; ++kb)
#pragma unroll
        for (int i = 0; i < 16; ++i) { const int key = key0 + 32 * kb + (i & 3) + 8 * (i >> 2) + 4 * h; const float v = mask(key) ? S[kb][i] * scale2 : -INFINITY; S[kb][i] = v; cmax = fmaxf(cmax, v); }
    cmax = fmaxf(cmax, __shfl_xor(cmax, 32));
    const float mn = fmaxf(mx, cmax), al = __builtin_amdgcn_exp2f(mx - mn); mx = mn; l *= al;
#pragma unroll
    for (int db = 0; db < NDB; ++db)
#pragma unroll
        for (int i = 0; i < 16; ++i) o[db][i] *= al;
    float ps = 0.f;
#pragma unroll
    for (int kb = 0; kb < NKB; ++kb)
#pragma unroll
        for (int i = 0; i < 16; ++i) { const float p = __builtin_amdgcn_exp2f(S[kb][i] - mn); S[kb][i] = p; ps += p; }
    ps += __shfl_xor(ps, 32); l += ps;
#pragma unroll
    for (int kb = 0; kb < NKB; ++kb)
#pragma unroll
        for (int s2 = 0; s2 < 2; ++s2) {
            u32x4 pw; pw.x = pg8::cvt_pk_bf16(S[kb][8 * s2], S[kb][8 * s2 + 1]); pw.y = pg8::cvt_pk_bf16(S[kb][8 * s2 + 2], S[kb][8 * s2 + 3]);
            pw.z = pg8::cvt_pk_bf16(S[kb][8 * s2 + 4], S[kb][8 * s2 + 5]); pw.w = pg8::cvt_pk_bf16(S[kb][8 * s2 + 6], S[kb][8 * s2 + 7]);
            const bf16x8 Pf = __builtin_bit_cast(bf16x8, pw);
#pragma unroll
            for (int db = 0; db < NDB; ++db) { const bf16* vp = VT + (32 * db + r) * VP + key0 + 32 * kb + 16 * s2 + 4 * h;
                const u32x2v lo = *(const u32x2v*)vp, hi = *(const u32x2v*)(vp + 8); u32x4 av; av.x = lo.x; av.y = lo.y; av.z = hi.x; av.w = hi.y;
                o[db] = MFMA32(__builtin_bit_cast(bf16x8, av), Pf, o[db]); }
            __builtin_amdgcn_sched_barrier(0);
        }
}
template <int NDB>
__device__ __forceinline__ void attn_store(const f32x16 (&o)[NDB], float l, bf16* orow, int lane) {
    const int h = lane >> 5; const float il = 1.0f / l;
#pragma unroll
    for (int db = 0; db < NDB; ++db)
#pragma unroll
        for (int i = 0; i < 4; ++i) { u32x2v w; w.x = pg8::cvt_pk_bf16(o[db][4 * i] * il, o[db][4 * i + 1] * il); w.y = pg8::cvt_pk_bf16(o[db][4 * i + 2] * il, o[db][4 * i + 3] * il);
            *(u32x2v*)(orow + 32 * db + 8 * i + 4 * h) = w; }
}
__device__ __forceinline__ void load_q64_rope(const bf16* qrow, const float* cs, bf16x8 (&q)[4], int lane) {
    const int h = lane >> 5;
#pragma unroll
    for (int ks = 0; ks < 4; ++ks) q[ks] = *(const bf16x8*)(qrow + 16 * ks + 8 * h);
    float my[8], ot[8]; unpack8(__builtin_bit_cast(v4u, q[0]), my);
#pragma unroll
    for (int i = 0; i < 8; ++i) ot[i] = __shfl_xor(my[i], 32);
#pragma unroll
    for (int i = 0; i < 8; ++i) { const float c = cs[2 * i], s = cs[2 * i + 1]; my[i] = h ? (my[i] * c + ot[i] * s) : (my[i] * c - ot[i] * s); }
    q[0] = __builtin_bit_cast(bf16x8, pack8c(my));
}
__device__ __forceinline__ void stage_k_chunk(bf16* Kt, int KP, int row, int c, const bf16* krow, const float* cs) {
    if (c == 1 && cs) return;
    if (!krow) { const v4u z = {0u, 0u, 0u, 0u}; *(v4u*)(Kt + row * KP + c * 8) = z; if (c == 0 && cs) *(v4u*)(Kt + row * KP + 8) = z; return; }
    if (c == 0 && cs) { float x1[8], x2[8]; unpack8(*(const v4u*)krow, x1); unpack8(*(const v4u*)(krow + 8), x2); float a[8], b[8];
#pragma unroll
        for (int i = 0; i < 8; ++i) { const float co = cs[2 * i], si = cs[2 * i + 1]; a[i] = x1[i] * co - x2[i] * si; b[i] = x2[i] * co + x1[i] * si; }
        *(v4u*)(Kt + row * KP) = pack8c(a); *(v4u*)(Kt + row * KP + 8) = pack8c(b); return; }
    *(v4u*)(Kt + row * KP + c * 8) = *(const v4u*)(krow + c * 8);
}
__device__ __forceinline__ void stage_vt_chunk(bf16* VT, int VP, int row, int c, v4u v) {
    bf16* p = VT + (c * 8) * VP + row;
    p[0] = (bf16)(v.x & 0xffffu); p[VP] = (bf16)(v.x >> 16); p[2 * VP] = (bf16)(v.y & 0xffffu); p[3 * VP] = (bf16)(v.y >> 16);
    p[4 * VP] = (bf16)(v.z & 0xffffu); p[5 * VP] = (bf16)(v.z >> 16); p[6 * VP] = (bf16)(v.w & 0xffffu); p[7 * VP] = (bf16)(v.w >> 16);
}
__device__ __forceinline__ v4u ld8_f32_as_bf16(const float* p) { const f32x4 a = *(const f32x4*)p, b = *(const f32x4*)(p + 4); v4u w; w.x = pg8::cvt_pk_bf16(a.x, a.y); w.y = pg8::cvt_pk_bf16(a.z, a.w); w.z = pg8::cvt_pk_bf16(b.x, b.y); w.w = pg8::cvt_pk_bf16(b.z, b.w); return w; }

constexpr int SKP = 72, SVP = 196;
__device__ __forceinline__ void p2_phase(Frame& F) {
    const int nthr = F.G * 512, gt = blockIdx.x * 512 + F.tid;
    for (int idx = gt; idx < NBP * 3 * CONVD; idx += nthr) { const int b = idx / (3 * CONVD), i = (idx / CONVD) % 3, ch = idx % CONVD;
        F.out[O_PCONV + idx] = bf2f(F.PROJ()[(size_t)(b * SEQ + SEQ - 3 + i) * NPROJ + C_X + ch]); }
    for (int idx = gt; idx < NBS * 3 * CONVD; idx += nthr) { const int b = idx / (3 * CONVD), i = (idx / CONVD) % 3, ch = idx % CONVD;
        F.out[O_SCONV + idx] = bf2f(F.PROJ()[(size_t)(MP + 4 * b + 1 + i) * NPROJ + C_X + ch]); }
    bf16* Kt = (bf16*)(F.lds + RING_OFF); bf16* VT = Kt + 192 * SKP;
    const int lane = F.lane, r = lane & 31;
    for (int it = F.vcu; it < 512; it += F.G) {
        __syncthreads();
        if (it < 256) {
            const int b = it >> 6, tile = (it >> 1) & 31, g = it & 1, t0 = tile * 64;
            { v4u kq[3], k2[3], vq[3];
#pragma unroll
              for (int i = 0; i < 3; ++i) { const int ci = F.tid + 512 * i, row = ci >> 3, c = ci & 7, s = t0 - 128 + row; const bool ok = (s >= 0 && s < SEQ);
                  const bf16* pr = F.PROJ() + (size_t)(b * SEQ + (ok ? s : 0)) * NPROJ;
                  kq[i] = *(const v4u*)(pr + C_K + g * 64 + c * 8); vq[i] = *(const v4u*)(pr + C_V + g * 64 + c * 8); k2[i] = kq[i]; if (c == 0) k2[i] = *(const v4u*)(pr + C_K + g * 64 + 8); }
#pragma unroll
              for (int i = 0; i < 3; ++i) { const int ci = F.tid + 512 * i, row = ci >> 3, c = ci & 7, s = t0 - 128 + row; const bool ok = (s >= 0 && s < SEQ);
                  const v4u z4 = {0u, 0u, 0u, 0u};
                  stage_vt_chunk(VT, SVP, row, c, ok ? vq[i] : z4);
                  if (c == 0) { float x1[8], x2[8], a[8], bb[8]; unpack8(kq[i], x1); unpack8(k2[i], x2); const float* cs = F.ROPE() + (size_t)(ok ? s : 0) * 16;
#pragma unroll
                      for (int e = 0; e < 8; ++e) { const float co = cs[2 * e], si = cs[2 * e + 1]; a[e] = x1[e] * co - x2[e] * si; bb[e] = x2[e] * co + x1[e] * si; }
                      *(v4u*)(Kt + row * SKP) = ok ? pack8c(a) : z4; *(v4u*)(Kt + row * SKP + 8) = ok ? pack8c(bb) : z4; }
                  else if (c >= 2) *(v4u*)(Kt + row * SKP + c * 8) = ok ? kq[i] : z4; } }
            __syncthreads();
            if (tile == 31) {
                for (int e = F.tid; e < 128 * 64; e += 512) { const int j = e >> 6, d = e & 63; const size_t o = ((size_t)(b * 128 + j) * 2 + g) * 64 + d;
                    F.out[O_PSK + o] = bf2f(Kt[(64 + j) * SKP + d]); F.out[O_PSV + o] = bf2f(VT[d * SVP + 64 + j]); } }
            const int head = g * 8 + F.wave; const float sink2 = F.in[I_SINKS][head] * LOG2E;
#pragma unroll 1
            for (int qb = 0; qb < 2; ++qb) {
                const int t = t0 + 32 * qb + r; const size_t m = (size_t)b * SEQ + t;
                bf16x8 q[4]; load_q64_rope(F.PROJ() + m * NPROJ + C_Q + head * 64, F.ROPE() + (size_t)t * 16, q, lane);
                float mx = sink2, l = 1.0f; f32x16 o[2];
#pragma unroll
                for (int db = 0; db < 2; ++db)
#pragma unroll
                    for (int i = 0; i < 16; ++i) o[db][i] = 0.f;
                const int relb = 32 * qb + r + 128;
                attn_chunk<5, 4, 2>(Kt, SKP, VT, SVP, 32 * qb, q, 0.125f * LOG2E, [=](int key) { const int rel = relb - key; return rel >= 0 && rel < 128 && (t0 - 128 + key) >= 0; }, mx, l, o, lane);
                attn_store<2>(o, l, F.YATT() + m * DM + 1024 + head * 64, lane);
            }
        } else {
            const int b = (it - 256) >> 1, g = it & 1;
            { f32x4 kc[4], vc[4];
#pragma unroll
              for (int i = 0; i < 4; ++i) { const int ci = F.tid + 512 * i, row = ci >> 4, c16 = ci & 15; const size_t o = ((size_t)(b * 128 + row) * 2 + g) * 64 + c16 * 4;
                  kc[i] = *(const f32x4*)(F.in[I_CSK] + o); vc[i] = *(const f32x4*)(F.in[I_CSV] + o); }
#pragma unroll
              for (int i = 0; i < 4; ++i) { const int ci = F.tid + 512 * i, row = ci >> 4, c16 = ci & 15;
                  u32x2v kw; kw.x = pg8::cvt_pk_bf16(kc[i].x, kc[i].y); kw.y = pg8::cvt_pk_bf16(kc[i].z, kc[i].w); *(u32x2v*)(Kt + row * SKP + c16 * 4) = kw;
                  bf16* vp = VT + (c16 * 4) * SVP + row; const unsigned v01 = pg8::cvt_pk_bf16(vc[i].x, vc[i].y), v23 = pg8::cvt_pk_bf16(vc[i].z, vc[i].w);
                  vp[0] = (bf16)(v01 & 0xffffu); vp[SVP] = (bf16)(v01 >> 16); vp[2 * SVP] = (bf16)(v23 & 0xffffu); vp[3 * SVP] = (bf16)(v23 >> 16); } }
            for (int ci = F.tid; ci < 32 * 8; ci += 512) { const int row = 128 + (ci >> 3), c = ci & 7;
                if (row < 132) { const int tt = row - 128; const bf16* pr = F.PROJ() + (size_t)(MP + 4 * b + tt) * NPROJ;
                    stage_k_chunk(Kt, SKP, row, c, pr + C_K + g * 64, F.ROPE() + (size_t)(2048 + tt) * 16); stage_vt_chunk(VT, SVP, row, c, *(const v4u*)(pr + C_V + g * 64 + c * 8));
                } else { const v4u z = {0u, 0u, 0u, 0u}; *(v4u*)(Kt + row * SKP + c * 8) = z; stage_vt_chunk(VT, SVP, row, c, z); } }
            __syncthreads();
#pragma unroll
            for (int i = 0; i < 4; ++i) { const int e = F.tid + 512 * i, j = e >> 4, d = (e & 15) * 4; const size_t o = ((size_t)(b * 128 + j) * 2 + g) * 64 + d;
                f32x4 kk, vv;
                if (j < 124) { const size_t si = ((size_t)(b * 128 + j + 4) * 2 + g) * 64 + d; kk = ldnt((const f32x4*)(F.in[I_CSK] + si)); vv = ldnt((const f32x4*)(F.in[I_CSV] + si)); }
                else { const bf16* kr = Kt + (4 + j) * SKP + d; kk = (f32x4){bf2f(kr[0]), bf2f(kr[1]), bf2f(kr[2]), bf2f(kr[3])};
                       vv = (f32x4){bf2f(VT[d * SVP + 4 + j]), bf2f(VT[(d + 1) * SVP + 4 + j]), bf2f(VT[(d + 2) * SVP + 4 + j]), bf2f(VT[(d + 3) * SVP + 4 + j])}; }
                stnt((f32x4*)(F.out + O_SSK + o), kk); stnt((f32x4*)(F.out + O_SSV + o), vv); }
            if (F.wave == 0) {
                const int head = g * 8 + (r >> 2), tok = r & 3; const size_t m = (size_t)MP + 4 * b + tok;
                bf16x8 q[4]; load_q64_rope(F.PROJ() + m * NPROJ + C_Q + head * 64, F.ROPE() + (size_t)(2048 + tok) * 16, q, lane);
                float mx = F.in[I_SINKS][head] * LOG2E, l = 1.0f; f32x16 o[2];
#pragma unroll
                for (int db = 0; db < 2; ++db)
#pragma unroll
                    for (int i = 0; i < 16; ++i) o[db][i] = 0.f;
                attn_chunk<5, 4, 2>(Kt, SKP, VT, SVP, 0, q, 0.125f * LOG2E, [=](int key) { return key > tok && key <= tok + 128; }, mx, l, o, lane);
                attn_store<2>(o, l, F.YATT() + m * DM + 1024 + head * 64, lane);
            }
        }
    }
}

constexpr int XKP = 136, XVP = 260;
__device__ __forceinline__ void p7_phase(Frame& F) {
    const int lane = F.lane, r = lane & 31;
    const bool split = (F.G == 256); const int hv = F.vcu >> 1; const bool odd = F.vcu & 1;
    const int pit0 = split ? (odd ? 256 : 2 * hv) : F.vcu, pit1 = split ? (odd ? 0 : 2 * hv + 2) : 256, pstep = split ? 1 : F.G;
    const int sit0 = split ? (odd ? 128 + 3 * hv : hv) : (int)blockIdx.x, scnt = split ? (odd ? 3 : 1) : (512 - (int)blockIdx.x + F.G - 1) / F.G, sstep = split ? 1 : F.G;
#ifndef XA_NO_PROMPT
    { bf16* Kt = (bf16*)(F.lds + RING_OFF); bf16* VT = Kt + 256 * XKP;
      for (int it = pit0; it < pit1; it += pstep) {
        const int b = it >> 6, hh = (it >> 4) & 3, tile = it & 15; const size_t m0 = (size_t)b * SEQ + tile * 128;
        __syncthreads();
        { v4u kq[8], vq[8];
#pragma unroll
          for (int i = 0; i < 8; ++i) { const int ci = F.tid + 512 * i, row = ci >> 4, c = ci & 15; const bf16* src = F.MKV() + (size_t)(b * NMEM + row) * 1024 + hh * 128 + c * 8; kq[i] = *(const v4u*)src; vq[i] = *(const v4u*)(src + 512); }
#pragma unroll
          for (int i = 0; i < 8; ++i) { const int ci = F.tid + 512 * i, row = ci >> 4, c = ci & 15; *(v4u*)(Kt + row * XKP + c * 8) = kq[i]; stage_vt_chunk(VT, XVP, row, c, vq[i]); } }
        __syncthreads();
        if (F.wave < 4) { const size_t m = m0 + 32 * F.wave + r;
            bf16x8 q[8];
#pragma unroll
            for (int ks = 0; ks < 8; ++ks) q[ks] = *(const bf16x8*)(F.QX() + m * XW + hh * 128 + 16 * ks + 8 * (lane >> 5));
            float mx = -INFINITY, l = 0.f; f32x16 o[4];
#pragma unroll
            for (int db = 0; db < 4; ++db)
#pragma unroll
                for (int i = 0; i < 16; ++i) o[db][i] = 0.f;
#pragma unroll 1
            for (int kc = 0; kc < 256; kc += 64) attn_chunk<2, 8, 4>(Kt, XKP, VT, XVP, kc, q, 0.08838834764831845f * LOG2E, [](int) { return true; }, mx, l, o, lane);
            attn_store<4>(o, l, F.OX() + m * XW + hh * 128, lane); }
      } }
#endif
#ifndef XA_NO_SAMPLE
    { float* qs = (float*)(F.lds + RING_OFF); float* S = qs + 4 * 128; float* red = S + 4 * 256;
      const int d4 = F.tid & 31, kg = F.tid >> 5, kh = (F.lane >> 5) & 1;
      f32x4 kq[16], vq[16];
#define XA_LOADK(it_, on_) do { const float* kr_ = (on_) ? F.in[I_CMK] + ((size_t)(((it_) >> 2) * NMEM + 32 * F.wave + kh) * 4 + ((it_) & 3)) * 128 + 4 * d4 : F.in[I_CMK]; const size_t ks_ = (on_) ? 1024 : 0; \
        _Pragma("unroll") for (int i = 0; i < 16; ++i) kq[i] = ldnt((const f32x4*)(kr_ + (size_t)i * ks_)); } while (0)
#define XA_LOADV(it_, on_) do { const float* vr_ = (on_) ? F.in[I_CMV] + ((size_t)(((it_) >> 2) * NMEM + kg * 16) * 4 + ((it_) & 3)) * 128 + 4 * d4 : F.in[I_CMV]; const size_t vs_ = (on_) ? 512 : 0; \
        _Pragma("unroll") for (int kk = 0; kk < 16; ++kk) vq[kk] = ldnt((const f32x4*)(vr_ + (size_t)kk * vs_)); } while (0)
#define XA_LOADQ(it_) F.QX()[((size_t)MP + 4 * ((it_) >> 2) + (F.tid >> 7)) * XW + ((it_) & 3) * 128 + (F.tid & 127)]
      int it = sit0; bf16 qn = 0;
      if (scnt > 0) { qn = XA_LOADQ(it); XA_LOADK(it, true); XA_LOADV(it, true); }
      for (int left = scnt; left > 0; --left, it += sstep) {
        const int b = it >> 2, hh = it & 3; const size_t m0 = (size_t)MP + 4 * b; const bool more = left > 1;
        __syncthreads();
        { const int t = F.tid >> 7, d = F.tid & 127; qs[t * 128 + d] = bf2f(qn) * 0.08838834764831845f; }
        __syncthreads();
        { const f32x4 q0 = *(const f32x4*)(qs + 4 * d4), q1 = *(const f32x4*)(qs + 128 + 4 * d4), q2 = *(const f32x4*)(qs + 256 + 4 * d4), q3 = *(const f32x4*)(qs + 384 + 4 * d4);
          const bool b4 = (F.lane >> 4) & 1, b3 = (F.lane >> 3) & 1;
#pragma unroll
          for (int i = 0; i < 16; ++i) { const f32x4 k4 = kq[i];
              float a0 = (k4.x * q0.x + k4.y * q0.y) + (k4.z * q0.z + k4.w * q0.w), a1 = (k4.x * q1.x + k4.y * q1.y) + (k4.z * q1.z + k4.w * q1.w);
              float a2 = (k4.x * q2.x + k4.y * q2.y) + (k4.z * q2.z + k4.w * q2.w), a3 = (k4.x * q3.x + k4.y * q3.y) + (k4.z * q3.z + k4.w * q3.w);
              { const float s0 = b4 ? a0 : a2, s1 = b4 ? a1 : a3, k0 = b4 ? a2 : a0, k1 = b4 ? a3 : a1; a0 = k0 + __shfl_xor(s0, 16); a1 = k1 + __shfl_xor(s1, 16); }
              { const float s0 = b3 ? a0 : a1, k0 = b3 ? a1 : a0; a0 = k0 + __shfl_xor(s0, 8); }
              a0 += __shfl_xor(a0, 4); a0 += __shfl_xor(a0, 2); a0 += __shfl_xor(a0, 1);
              if ((F.lane & 7) == 0) S[(2 * (int)b4 + (int)b3) * 256 + 32 * F.wave + 2 * i + kh] = a0; } }
        { const int itn = more ? it + sstep : it; qn = XA_LOADQ(itn); XA_LOADK(itn, more); }
        __syncthreads();
        if (F.wave < 4) { float v[4]; float mx = -INFINITY;
#pragma unroll
            for (int i = 0; i < 4; ++i) { v[i] = S[F.wave * 256 + lane + 64 * i]; mx = fmaxf(mx, v[i]); }
#pragma unroll
            for (int o = 1; o < 64; o <<= 1) mx = fmaxf(mx, __shfl_xor(mx, o));
            float s = 0.f;
#pragma unroll
            for (int i = 0; i < 4; ++i) { v[i] = __expf(v[i] - mx); s += v[i]; }
            s = 1.0f / wave_sum(s);
#pragma unroll
            for (int i = 0; i < 4; ++i) S[F.wave * 256 + lane + 64 * i] = v[i] * s; }
        __syncthreads();
        { f32x4 acc[4];
#pragma unroll
          for (int t = 0; t < 4; ++t) acc[t] = (f32x4){0.f, 0.f, 0.f, 0.f};
#pragma unroll
          for (int kk = 0; kk < 16; ++kk) { const int ky = kg * 16 + kk;
#pragma unroll
              for (int t = 0; t < 4; ++t) acc[t] = acc[t] + vq[kk] * S[t * 256 + ky]; }
#pragma unroll
          for (int t = 0; t < 4; ++t) *(f32x4*)(red + (kg * 4 + t) * 128 + 4 * d4) = acc[t]; }
        { const int itn = more ? it + sstep : it; XA_LOADV(itn, more); }
        __syncthreads();
        { const int t = F.tid >> 7, d = F.tid & 127; float s = 0.f;
#pragma unroll
          for (int q = 0; q < 16; ++q) s += red[(q * 4 + t) * 128 + d];
          F.OX()[(m0 + t) * XW + hh * 128 + d] = (bf16)f2bf(s); }
      }
#undef XA_LOADK
#undef XA_LOADQ
#undef XA_LOADV
    }
#endif
}
__device__ __forceinline__ void p11_phase(Frame& F) {
    const int gw = blockIdx.x * NWAVES + F.wave, NGW = F.G * NWAVES;
    f32x4 g[8];
#pragma unroll
    for (int j = 0; j < 8; ++j) g[j] = ((const f32x4*)F.in[I_NFINAL])[F.lane + 64 * j];
    u32x2v cur[8], nxt[8];
    if (gw < M) { const u32x2v* xr = (const u32x2v*)(F.XB() + (size_t)gw * DM) + F.lane;
#pragma unroll
        for (int j = 0; j < 8; ++j) cur[j] = xr[64 * j]; }
#pragma unroll 1
    for (int m = gw; m < M; m += NGW) {
        { const int ml = (m + NGW < M) ? m + NGW : m; const u32x2v* xr = (const u32x2v*)(F.XB() + (size_t)ml * DM) + F.lane;
#pragma unroll
          for (int j = 0; j < 8; ++j) nxt[j] = xr[64 * j]; }
        f32x4 v[8]; float s = 0.f;
#pragma unroll
        for (int j = 0; j < 8; ++j) { const u32x2v q = cur[j]; v[j] = (f32x4){__uint_as_float(q.x << 16), __uint_as_float(q.x & 0xffff0000u), __uint_as_float(q.y << 16), __uint_as_float(q.y & 0xffff0000u)}; }
        if (F.G == 256 && m >= MP) {
            const f32x4* sl = (const f32x4*)((const float*)(F.ws + WS_SLAB) + (size_t)(m - MP) * DM) + F.lane;
#pragma unroll 2
            for (int q = 0; q < 8; ++q)
#pragma unroll
                for (int j = 0; j < 8; ++j) v[j] = v[j] + sl[(size_t)q * (512 * DM / 4) + 64 * j]; }
#pragma unroll
        for (int j = 0; j < 8; ++j) s += (v[j].x * v[j].x + v[j].y * v[j].y) + (v[j].z * v[j].z + v[j].w * v[j].w);
        const float rstd = 1.0f / sqrtf(wave_sum(s) * (1.0f / DM) + EPS);
        f32x4* orow = (f32x4*)(F.out + (size_t)m * DM) + F.lane;
#pragma unroll
        for (int j = 0; j < 8; ++j) stnt(orow + 64 * j, v[j] * rstd * g[j]);
#pragma unroll
        for (int j = 0; j < 8; ++j) cur[j] = nxt[j];
    }
}
struct Args { const float* in[30]; float* out; unsigned char* ws; int ph_lo, ph_hi, li, pad; };
__global__ void __launch_bounds__(NWAVES * 64, 2) hymba_fwd(Args args) {
    extern __shared__ __attribute__((aligned(16))) unsigned char lds[];
    Frame F;
    F.lds = lds; F.ldsl = (LAS unsigned char*)lds;
    F.MISC = (volatile LAS unsigned*)(F.ldsl + MISC_OFF);
    F.tid = threadIdx.x; F.lane = F.tid & 63; F.wave = __builtin_amdgcn_readfirstlane(F.tid >> 6); F.G = gridDim.x; { const int bx = blockIdx.x; F.vcu = (F.G % 8 == 0) ? (bx % 8) * (F.G / 8) + bx / 8 : bx; }
    unsigned char* ws = args.ws; F.ws = ws; F.out = args.out;
#pragma unroll
    for (int i = 0; i < 30; ++i) F.in[i] = args.in[i];
    F.ctl = (gu32*)(ws + WS_CTL);
    for (int u = F.tid; u < (LDS_BYTES - LDSCTL_OFF) / 4; u += NWAVES * 64) ((LAS unsigned*)(F.ldsl + LDSCTL_OFF))[u] = 0u;
    __syncthreads();
    XcdBarrier bar; bar.bar = (unsigned*)(F.ctl + CW_BAR) + args.li * XCD_BAR_WORDS; bar.x = 0; bar.st = nullptr;
    if (MK_ONE_LAUNCH) bar = xcd_barrier_post((unsigned*)(F.ctl + CW_BAR) + args.li * XCD_BAR_WORDS, F.MISC + 8);
#define GRID_BAR() do { if (MK_ONE_LAUNCH) xcd_barrier(bar); } while (0)
    const int lo = args.ph_lo, hi = args.ph_hi;
#ifndef P0PARTS
#define P0PARTS 7
#endif
#ifndef P2PARTS
#define P2PARTS 3
#endif
#ifndef DUPMASK
#define DUPMASK 0
#endif
#ifndef PHMASK
#define PHMASK 0x1FFF
#endif
#define IN(k) (((PHMASK >> (k)) & 1) && lo <= (k) && (k) < hi)
#define BOTH(k) (IN(k) && IN((k) + 1))
    float* const xres = F.out + O_Y;

#define DUP(k) ((DUPMASK >> (k)) & 1)
    if (IN(0)) { p0_prologue(F, args.li == 1 ? P0PARTS : 7); if (BOTH(0)) GRID_BAR(); if (DUP(0)) { p0_prologue(F); GRID_BAR(); } }
    if (IN(1)) {
        pg8::Gemm g{F.XB(), F.Wt_in(), M, NPROJ, DM}; pg8::StaticOrder S; S.init(M, NPROJ, F.G, (int)blockIdx.x);
        pg8::EpiBf16S E{F.PROJ(), NPROJ, nullptr};
        pg8::gemm_phase<pg8::EpiBf16S, pg8::StaticOrder, PG8_ALIGN, PG8_SP2>(F.ldsl + RING_OFF, g, S, E);
        if (BOTH(1)) GRID_BAR();
        if (DUP(1)) { pg8::gemm_phase<pg8::EpiBf16S, pg8::StaticOrder, PG8_ALIGN, PG8_SP2>(F.ldsl + RING_OFF, g, S, E); GRID_BAR(); }
    }
    if (IN(2)) { if (args.li != 1 || (P2PARTS & 1)) conv_phase(F); if (args.li != 1 || (P2PARTS & 2)) p2_phase(F); if (BOTH(2)) GRID_BAR(); if ((DUPMASK >> 2) & 1) { if (P2PARTS & 1) conv_phase(F); if (P2PARTS & 2) p2_phase(F); GRID_BAR(); } }
    if (IN(3)) { ssd_p3_phase(F); if (BOTH(3)) GRID_BAR(); if (DUP(20)) { for (int q = 0; q < 8; ++q) GRID_BAR(); } if (DUP(3)) { ssd_p3_phase(F); GRID_BAR(); } }
    if (IN(4)) { ssd_p4_phase(F); if (BOTH(4)) GRID_BAR(); if (DUP(4)) { ssd_p4_phase(F); GRID_BAR(); } }
    if (IN(5)) {
#pragma unroll 1
        for (int rep = 0; rep < 1 + DUP(5); ++rep) { ssd_p5_phase(F); if (BOTH(5)) GRID_BAR(); } }
    if (IN(6)) {
        pg8::Gemm g{F.YATT(), F.Wt_out(), M, DM, DM};
        if (F.G == 256) {
            pg8::TailOrder S; S.init(MP, DM, F.G, (int)blockIdx.x); S.mode = 1;
            pg8::EpiResidB<true, true> E{F.in[I_XP], F.in[I_XS], F.XB(), F.SSQ1(), F.RG(), (float*)(ws + WS_ST), F.XB()};
            pg8::gemm_phase<pg8::EpiResidB<true, true>, pg8::TailOrder, PG8_ALIGN, PG8_SP2>(F.ldsl + RING_OFF, g, S, E);
            GRID_BAR();
            for (int r = blockIdx.x * NWAVES + F.wave; r < MS; r += F.G * NWAVES) {
                const float* xr = F.in[I_XS] + (size_t)r * DM + 8 * F.lane; const float* sl = (const float*)(ws + WS_ST) + (size_t)r * DM + 8 * F.lane; float v[4][8];
#pragma unroll
                for (int j = 0; j < 4; ++j) { const f32x4 a = *(const f32x4*)(xr + 512 * j), b = *(const f32x4*)(xr + 512 * j + 4); v[j][0] = a.x; v[j][1] = a.y; v[j][2] = a.z; v[j][3] = a.w; v[j][4] = b.x; v[j][5] = b.y; v[j][6] = b.z; v[j][7] = b.w; }
#pragma unroll 2
                for (int q = 0; q < 8; ++q)
#pragma unroll
                    for (int j = 0; j < 4; ++j) { const f32x4 a = *(const f32x4*)(sl + (size_t)q * 512 * DM + 512 * j), b = *(const f32x4*)(sl + (size_t)q * 512 * DM + 512 * j + 4);
                        v[j][0] += a.x; v[j][1] += a.y; v[j][2] += a.z; v[j][3] += a.w; v[j][4] += b.x; v[j][5] += b.y; v[j][6] += b.z; v[j][7] += b.w; }
                float s = 0.f;
#pragma unroll
                for (int j = 0; j < 4; ++j) {
#pragma unroll
                    for (int i = 0; i < 8; ++i) s += v[j][i] * v[j][i];
                    *(v4u*)(F.XB() + (size_t)(MP + r) * DM + 8 * F.lane + 512 * j) = pack8c(v[j]); }
                s = wave_sum(s); if (F.lane == 0) F.SSQ1()[MP + r] = s;
            }
        } else {
            pg8::StaticOrder S; S.init(M, DM, F.G, (int)blockIdx.x);
            pg8::EpiResidB<true, true> E{F.in[I_XP], F.in[I_XS], F.XB(), F.SSQ1(), F.RG(), nullptr, F.XB()};
            pg8::gemm_phase<pg8::EpiResidB<true, true>, pg8::StaticOrder, PG8_ALIGN, PG8_SP2>(F.ldsl + RING_OFF, g, S, E);
        }
        if (BOTH(6)) GRID_BAR();
    }
    if (IN(7)) {
        { pg8::Gemm g{F.XB(), F.Wt_xq(), M, XW, DM}; pg8::StaticOrder S; S.init(M, XW, F.G, (int)blockIdx.x);
          pg8::EpiBf16S E{F.QX(), XW, F.SSQ1()};
          pg8::gemm_phase<pg8::EpiBf16S, pg8::StaticOrder, PG8_ALIGN, PG8_SP2>(F.ldsl + RING_OFF, g, S, E); }
        { pg8::Gemm g{F.MN(), F.Wt_kv(), MM, 1024, DM}; pg8::StaticOrder S; S.init(MM, 1024, F.G, (int)(F.G - 1 - blockIdx.x));
          pg8::EpiMemKV E{F.out + O_PMK, F.out + O_PMV, F.MKV()};
          pg8::gemm_phase<pg8::EpiMemKV, pg8::StaticOrder, PG8_ALIGN, PG8_SP2>(F.ldsl + RING_OFF, g, S, E); }
        ffn_weight_copies(F, 0, 68, F.G - 16);
        if (BOTH(7)) GRID_BAR();
        if (DUP(7)) { { pg8::Gemm g{F.XB(), F.Wt_xq(), M, XW, DM}; pg8::StaticOrder S; S.init(M, XW, F.G, (int)blockIdx.x); pg8::EpiBf16S E{F.QX(), XW, F.SSQ1()};
                        pg8::gemm_phase<pg8::EpiBf16S, pg8::StaticOrder, PG8_ALIGN, PG8_SP2>(F.ldsl + RING_OFF, g, S, E); } GRID_BAR(); }
    }
    if (IN(8)) {
#pragma unroll 1
        for (int rep = 0; rep < 1 + DUP(8); ++rep) { p7_phase(F); if (BOTH(8)) GRID_BAR(); } }
    if (IN(9)) {
        pg8::Gemm g{F.OX(), F.Wt_xo(), M, DM, XW}; pg8::StaticOrder S; S.init(M, DM, F.G, (int)blockIdx.x);
        pg8::EpiResidB<false, false> E{nullptr, nullptr, F.XB(), F.SSQ2(), nullptr, nullptr, F.XB()};
        pg8::gemm_phase<pg8::EpiResidB<false, false>, pg8::StaticOrder, PG8_ALIGN, PG8_SP2>(F.ldsl + RING_OFF, g, S, E);
        ffn_weight_copies(F, 1, 16, F.G);
        if (BOTH(9)) GRID_BAR();
        if (DUP(9)) { pg8::EpiResidB<false, false> E2{nullptr, nullptr, F.XB(), nullptr, nullptr, nullptr, (bf16*)(ws + WS_ST)}; pg8::gemm_phase<pg8::EpiResidB<false, false>, pg8::StaticOrder, PG8_ALIGN, PG8_SP2>(F.ldsl + RING_OFF, g, S, E2); GRID_BAR(); }
    }
    if (IN(10)) {
        pg8::Gemm g{F.XB(), F.Wt_gu(), M, 2 * DFF, DM}; pg8::StaticOrder S; S.init(M, 2 * DFF, F.G, (int)blockIdx.x);
        pg8::EpiSwiGLU E{F.ACT(), DFF, F.SSQ2()};
        pg8::gemm_phase<pg8::EpiSwiGLU, pg8::StaticOrder, PG8_ALIGN, PG8_SP2>(F.ldsl + RING_OFF, g, S, E);
        if (BOTH(10)) GRID_BAR();
        if ((DUPMASK >> 10) & 1) { pg8::gemm_phase<pg8::EpiSwiGLU, pg8::StaticOrder, PG8_ALIGN, PG8_SP2>(F.ldsl + RING_OFF, g, S, E); GRID_BAR(); }
    }
    if (IN(11)) {
        pg8::Gemm g{F.ACT(), F.Wt_dn(), M, DM, DFF};
        pg8::EpiResidB<false, false> E{nullptr, nullptr, F.XB(), nullptr, nullptr, (float*)(ws + WS_SLAB), F.XB()};
        if (F.G == 256) {
            pg8::TailOrder S; S.init(MP, DM, F.G, (int)blockIdx.x); S.mode = 0;
            pg8::gemm_phase<pg8::EpiResidB<false, false>, pg8::TailOrder, PG8_ALIGN, PG8_SP2>(F.ldsl + RING_OFF, g, S, E);
            if (DUP(11)) { GRID_BAR(); pg8::EpiResidB<false, false> E2{nullptr, nullptr, F.XB(), nullptr, nullptr, (float*)(ws + WS_SLAB), (bf16*)(ws + WS_ST)}; pg8::gemm_phase<pg8::EpiResidB<false, false>, pg8::TailOrder, PG8_ALIGN, PG8_SP2>(F.ldsl + RING_OFF, g, S, E2); }
        } else {
            pg8::StaticOrder S; S.init(M, DM, F.G, (int)blockIdx.x);
            pg8::gemm_phase<pg8::EpiResidB<false, false>, pg8::StaticOrder, PG8_ALIGN, PG8_SP2>(F.ldsl + RING_OFF, g, S, E);
        }
        if (BOTH(11)) GRID_BAR();
    }
    if (IN(12)) { p11_phase(F); }
#undef IN
#undef BOTH
}

extern "C" void kernel_launch(void* const* d_in, const int* in_sizes, int n_in, void* d_out, int out_size, void* d_ws, size_t ws_size, hipStream_t stream) {
    static int grid = 0;
    if (grid == 0) {
        if (n_in != 30 || in_sizes[0] != MP * DM || in_sizes[I_WIN] != DM * IN_DIM || (size_t)out_size != O_END || ws_size < WS_END) {
            fprintf(stderr, "kernel_launch: unexpected shapes: n_in %d in0 %d w_in %d out %d ws %zu; nothing launched\n", n_in, n_in > 0 ? in_sizes[0] : -1, n_in > 10 ? in_sizes[10] : -1, out_size, ws_size); grid = -1; return; }
        int dev = 0, cus = 0, per_cu = 0;
        if (hipGetDevice(&dev) != hipSuccess || hipDeviceGetAttribute(&cus, hipDeviceAttributeMultiprocessorCount, dev) != hipSuccess) { grid = -1; return; }
        if (hipFuncSetAttribute((const void*)hymba_fwd, hipFuncAttributeMaxDynamicSharedMemorySize, LDS_BYTES) != hipSuccess) { fprintf(stderr, "kernel_launch: hipFuncSetAttribute failed\n"); grid = -1; return; }
        if (hipOccupancyMaxActiveBlocksPerMultiprocessor(&per_cu, (const void*)hymba_fwd, NWAVES * 64, LDS_BYTES) != hipSuccess || per_cu < 1) { fprintf(stderr, "kernel_launch: occupancy query says %d blocks per CU\n", per_cu); per_cu = 1; }
        (void)hipGetLastError();
        grid = cus;
    }
    if (grid < 0) return;
    if (hipMemsetAsync((char*)d_ws + WS_CTL, 0, CTL_ZERO_BYTES, stream) != hipSuccess) { fprintf(stderr, "kernel_launch: memset failed\n"); return; }
    Args a{};
    for (int i = 0; i < 30; ++i) a.in[i] = (const float*)d_in[i];
    a.out = (float*)d_out; a.ws = (unsigned char*)d_ws;
    if (MK_ONE_LAUNCH) {
#ifdef PROBE_SPLIT_AT
        a.ph_lo = 0; a.ph_hi = PROBE_SPLIT_AT + 1; a.li = 0; hipLaunchKernelGGL(hymba_fwd, dim3(grid), dim3(NWAVES * 64), LDS_BYTES, stream, a);
        for (int q = 0; q < PROBE_REPS; ++q) { a.ph_lo = PROBE_SPLIT_AT; a.ph_hi = PROBE_SPLIT_AT + 1; a.li = 1; hipLaunchKernelGGL(hymba_fwd, dim3(grid), dim3(NWAVES * 64), LDS_BYTES, stream, a); }
        a.ph_lo = PROBE_SPLIT_AT + 1; a.ph_hi = NPHASE; a.li = 2; hipLaunchKernelGGL(hymba_fwd, dim3(grid), dim3(NWAVES * 64), LDS_BYTES, stream, a);
#else
        a.ph_lo = 0; a.ph_hi = NPHASE; a.li = 0;
        hipLaunchKernelGGL(hymba_fwd, dim3(grid), dim3(NWAVES * 64), LDS_BYTES, stream, a);
#endif
    } else {
        for (int p = 0; p < NPHASE; ++p) { a.ph_lo = p; a.ph_hi = p + 1; a.li = p; hipLaunchKernelGGL(hymba_fwd, dim3(grid), dim3(NWAVES * 64), LDS_BYTES, stream, a); }
    }
    const hipError_t le = hipPeekAtLastError();
    if (le != hipSuccess) fprintf(stderr, "kernel_launch: launch failed: %s\n", hipGetErrorName(le));
}
```

```cpp
#include <hip/hip_runtime.h>
#include <cstdio>
#include <cstdint>
#include <cmath>
namespace pg8 {
#define PG8_LAS __attribute__((address_space(3)))
typedef unsigned short bf16_t;
typedef short bf16x8 __attribute__((ext_vector_type(8)));
typedef float f32x4 __attribute__((ext_vector_type(4)));
typedef unsigned u32x4 __attribute__((ext_vector_type(4)));
constexpr int BM = 256, BK = 64, HALF = 128, HTB = HALF * BK * 2  , STAGE_BYTES = 8 * HTB, NXCD = 8, WGM = 8;

__host__ __device__ __forceinline__ int lds_byte(int r, int c) { const int st = (r >> 4) * 2 + (c >> 5), rr = r & 15, cc = c & 31, ob = rr * 64 + cc * 2; return st * 1024 + (ob ^ (((ob >> 9) & 1) << 5)); }
__host__ __device__ __forceinline__ void stage_rc(int b, int& R, int& C) { const int st = b / 1024, sb = b % 1024, swz = sb ^ (((sb >> 9) & 1) << 5); R = (st >> 1) * 16 + swz / 64; C = (st & 1) * 32 + (swz % 64) / 2; }
__host__ __device__ __forceinline__ int perm32(int rho) { const int n = rho >> 4, i = rho & 15; return 8 * (i >> 2) + 4 * n + (i & 3); }

struct Unit { int pm, pn, k0, nt, q; };
struct Gemm { const bf16_t* A; const bf16_t* Bt; int M, N, K; };

struct StaticOrder {
    int nM, nN, nwg, G, c;
    __host__ __device__ void init(int M, int N, int G_, int c_) { nM = M / BM; nN = N / BM; nwg = nM * nN; G = G_; c = c_; }
    __host__ __device__ bool next(int i, Unit& u) const {
        const long L = (long)i * G + c; if (L >= nwg) return false;
        int wgid = (int)L; { const int q = nwg / NXCD, r = nwg % NXCD, xcd = wgid % NXCD, off = wgid / NXCD; wgid = (xcd < r ? xcd * (q + 1) : r * (q + 1) + (xcd - r) * q) + off; }
        const int nig = WGM * nN, gid = wgid / nig, fm = gid * WGM, gsz = (nM - fm) < WGM ? (nM - fm) : WGM;
        u.pm = fm + ((wgid % nig) % gsz); u.pn = (wgid % nig) / gsz; u.k0 = 0; u.nt = 0; u.q = -1; return true;
    }
    __device__ __forceinline__ void a_ready(const Unit&) const {}
    __device__ __forceinline__ void done(const Unit&) const {}
};
struct TailOrder : StaticOrder {
    int mode;
    __host__ __device__ bool next(int i, Unit& u) const {
        if (i == 0) return StaticOrder::next(0, u);
        if (i == 1 && c < 128) { const int j = c >> 3, q = c & 7; u.pm = 32 + (j >> 3); u.pn = j & 7; u.q = q;
            if (mode == 0) { u.k0 = q < 4 ? 12 * q : 48 + 10 * (q - 4); u.nt = q < 4 ? 12 : 10; } else { u.k0 = 4 * q; u.nt = 4; }
            return true; }
        return false;
    }
};

typedef float f32x2_t __attribute__((ext_vector_type(2))); typedef __bf16 bf16x2_t __attribute__((ext_vector_type(2)));
__device__ __forceinline__ unsigned cvt_pk_bf16(float lo, float hi) { f32x2_t v = {lo, hi}; bf16x2_t b = __builtin_convertvector(v, bf16x2_t); return __builtin_bit_cast(unsigned, b); }
typedef unsigned u32x2 __attribute__((ext_vector_type(2)));
constexpr float RMS_EPS = 1e-5f;
constexpr int ROWS_P = 8192;
struct EpiBf16S {
    static constexpr bool PERM = true, AFTER_DRAIN = false, KHOOK = false;
    bf16_t* O; int ldc; const float* ssq;
    __device__ __forceinline__ void operator()(const f32x4 (&acc)[2][2][4][2], const Unit& u, int wr, int wc, int fr, int fq) const {
        const int row0 = u.pm * BM + wr * 64 + fr, col0 = u.pn * BM + wc * 32 + 8 * fq;
        float scv[2][4];
        if (ssq) {
#pragma unroll
            for (int ai = 0; ai < 2; ++ai)
#pragma unroll
                for (int m = 0; m < 4; ++m) scv[ai][m] = ssq[row0 + ai * HALF + m * 16];
#pragma unroll
            for (int ai = 0; ai < 2; ++ai)
#pragma unroll
                for (int m = 0; m < 4; ++m) scv[ai][m] = 1.0f / sqrtf(scv[ai][m] * (1.0f / 2048.0f) + RMS_EPS);
        } else {
#pragma unroll
            for (int ai = 0; ai < 2; ++ai)
#pragma unroll
                for (int m = 0; m < 4; ++m) scv[ai][m] = 1.0f; }
#pragma unroll
        for (int ai = 0; ai < 2; ++ai)
#pragma unroll
            for (int m = 0; m < 4; ++m) { const int r = row0 + ai * HALF + m * 16; bf16_t* rowp = O + (size_t)r * ldc + col0;
                const float sc = scv[ai][m];
#pragma unroll
                for (int bj = 0; bj < 2; ++bj) { const f32x4 v0 = acc[ai][bj][m][0] * sc, v1 = acc[ai][bj][m][1] * sc;
                    u32x4 w; w.x = cvt_pk_bf16(v0[0], v0[1]); w.y = cvt_pk_bf16(v0[2], v0[3]); w.z = cvt_pk_bf16(v1[0], v1[1]); w.w = cvt_pk_bf16(v1[2], v1[3]);
                    *(u32x4*)(rowp + bj * HALF) = w; } }
    }
};
struct EpiSwiGLU {
    static constexpr bool PERM = true, AFTER_DRAIN = false, KHOOK = false;
    bf16_t* O; int ldc; const float* ssq;
    __device__ __forceinline__ void operator()(const f32x4 (&acc)[2][2][4][2], const Unit& u, int wr, int wc, int fr, int fq) const {
        const int row0 = u.pm * BM + wr * 64 + fr, col0 = u.pn * 128 + wc * 32 + 8 * fq;
        float scv[2][4];
#pragma unroll
        for (int ai = 0; ai < 2; ++ai)
#pragma unroll
            for (int m = 0; m < 4; ++m) scv[ai][m] = ssq[row0 + ai * HALF + m * 16];
#pragma unroll
        for (int ai = 0; ai < 2; ++ai)
#pragma unroll
            for (int m = 0; m < 4; ++m) { const int r = row0 + ai * HALF + m * 16;
                const float sc = __builtin_amdgcn_rsqf(scv[ai][m] * (1.0f / 2048.0f) + RMS_EPS), c2 = -1.4426950408889634f * sc, s2 = sc * sc;
                f32x4 a[2];
#pragma unroll
                for (int n = 0; n < 2; ++n) { const f32x4 g = acc[ai][0][m][n], up = acc[ai][1][m][n]; const f32x4 t = g * c2; f32x4 d;
#pragma unroll
                    for (int i = 0; i < 4; ++i) d[i] = __builtin_amdgcn_rcpf(1.0f + __builtin_amdgcn_exp2f(t[i]));
                    a[n] = (g * up) * (d * s2); }
                u32x4 w; w.x = cvt_pk_bf16(a[0][0], a[0][1]); w.y = cvt_pk_bf16(a[0][2], a[0][3]); w.z = cvt_pk_bf16(a[1][0], a[1][1]); w.w = cvt_pk_bf16(a[1][2], a[1][3]);
                *(u32x4*)(O + (size_t)r * ldc + col0) = w; }
    }
};
template <bool HOOK> struct EpiResid {
    static constexpr bool PERM = false, AFTER_DRAIN = false, KHOOK = HOOK;
    const float* baseP; const float* baseS; float* out; bf16_t* ob; float* ssq; const float* ssqh; float* slab;
    __device__ __forceinline__ void khook(f32x4 (&acc)[2][2][4][2], const Unit& u, int t, int wr, int wc, int fr, int fq) const {
        const float* bp = ssqh + (size_t)(u.pm * BM + wr * 64 + fr) * 2;
#pragma unroll
        for (int ai = 0; ai < 2; ++ai)
#pragma unroll
            for (int m = 0; m < 4; ++m) { const f32x2_t rg = *(const f32x2_t*)(bp + (ai * HALF + m * 16) * 2); const float r0 = rg[0], r1 = rg[1];
                const float f = (t == 8) ? r0 / r1 : r1;
#pragma unroll
                for (int bj = 0; bj < 2; ++bj)
#pragma unroll
                    for (int n = 0; n < 2; ++n) acc[ai][bj][m][n] = acc[ai][bj][m][n] * f; }
    }
    __device__ __forceinline__ void operator()(const f32x4 (&acc)[2][2][4][2], const Unit& u, int wr, int wc, int fr, int fq) const {
        const int row0 = u.pm * BM + wr * 64 + fr, col0 = u.pn * BM + wc * 32 + 4 * fq;
        if (u.q >= 0) {
            float* sp = slab + ((size_t)u.q * 512 + (row0 - ROWS_P)) * 2048 + col0;
#pragma unroll
            for (int ai = 0; ai < 2; ++ai)
#pragma unroll
                for (int m = 0; m < 4; ++m)
#pragma unroll
                    for (int bj = 0; bj < 2; ++bj)
#pragma unroll
                        for (int n = 0; n < 2; ++n) *(f32x4*)(sp + (size_t)(ai * HALF + m * 16) * 2048 + bj * HALF + n * 16) = acc[ai][bj][m][n];
            return; }
#pragma unroll
        for (int ai = 0; ai < 2; ++ai)
#pragma unroll
            for (int m = 0; m < 4; ++m) { const int r = row0 + ai * HALF + m * 16; const size_t off = (size_t)r * 2048 + col0;
                const float* bp = (r < ROWS_P) ? baseP + off : baseS + (off - (size_t)ROWS_P * 2048);
                float s = 0.f;
#pragma unroll
                for (int bj = 0; bj < 2; ++bj)
#pragma unroll
                    for (int n = 0; n < 2; ++n) { const f32x4 v = acc[ai][bj][m][n] + *(const f32x4*)(bp + bj * HALF + n * 16);
                        *(f32x4*)(out + off + bj * HALF + n * 16) = v; s += (v[0] * v[0] + v[1] * v[1]) + (v[2] * v[2] + v[3] * v[3]);
                        if (ob) { u32x2 w; w.x = cvt_pk_bf16(v[0], v[1]); w.y = cvt_pk_bf16(v[2], v[3]); *(u32x2*)(ob + off + bj * HALF + n * 16) = w; } }
                if (ssq) { s += __shfl_xor(s, 16); s += __shfl_xor(s, 32); if (fq == 0) atomicAdd(ssq + r, s); } }
    }
};
template <bool HOOK, bool F32BASE> struct EpiResidB {
    static constexpr bool PERM = true, AFTER_DRAIN = false, KHOOK = HOOK;
    const float* baseP; const float* baseS; bf16_t* xb; float* ssq; const float* rg; float* slab; bf16_t* xo;
    __device__ __forceinline__ void khook(f32x4 (&acc)[2][2][4][2], const Unit& u, int t, int wr, int wc, int fr, int fq) const {
        const float* bp = rg + (size_t)(u.pm * BM + wr * 64 + fr) * 2;
        f32x2_t g2[2][4];
#pragma unroll
        for (int ai = 0; ai < 2; ++ai)
#pragma unroll
            for (int m = 0; m < 4; ++m) g2[ai][m] = *(const f32x2_t*)(bp + (ai * HALF + m * 16) * 2);
#pragma unroll
        for (int ai = 0; ai < 2; ++ai)
#pragma unroll
            for (int m = 0; m < 4; ++m) { const float f = (t == 8) ? g2[ai][m][0] / g2[ai][m][1] : g2[ai][m][1];
#pragma unroll
                for (int bj = 0; bj < 2; ++bj)
#pragma unroll
                    for (int n = 0; n < 2; ++n) acc[ai][bj][m][n] = acc[ai][bj][m][n] * f; }
    }
    __device__ __forceinline__ void operator()(const f32x4 (&acc)[2][2][4][2], const Unit& u, int wr, int wc, int fr, int fq) const {
        const int row0 = u.pm * BM + wr * 64 + fr, col0 = u.pn * BM + wc * 32 + 8 * fq;
        if (u.q >= 0) {
            float* sp = slab + ((size_t)u.q * 512 + (row0 - ROWS_P)) * 2048 + col0;
            float fv[2][4];
#pragma unroll
            for (int ai = 0; ai < 2; ++ai)
#pragma unroll
                for (int m = 0; m < 4; ++m) fv[ai][m] = (HOOK && u.q < 4) ? rg[(size_t)(row0 + ai * HALF + m * 16) * 2 + (u.q >> 1)] : 1.0f;
#pragma unroll
            for (int ai = 0; ai < 2; ++ai)
#pragma unroll
                for (int m = 0; m < 4; ++m)
#pragma unroll
                    for (int bj = 0; bj < 2; ++bj)
#pragma unroll
                        for (int n = 0; n < 2; ++n) *(f32x4*)(sp + (size_t)(ai * HALF + m * 16) * 2048 + bj * HALF + 4 * n) = acc[ai][bj][m][n] * fv[ai][m];
            return; }
#pragma unroll
        for (int ai = 0; ai < 2; ++ai) {
            f32x4 rb[4][2][2];
            if constexpr (F32BASE) {
#pragma unroll
                for (int m = 0; m < 4; ++m) { const int r = row0 + ai * HALF + m * 16; const size_t off = (size_t)r * 2048 + col0;
                    const float* bp = (r < ROWS_P) ? baseP + off : baseS + (off - (size_t)ROWS_P * 2048);
#pragma unroll
                    for (int bj = 0; bj < 2; ++bj) { rb[m][bj][0] = *(const f32x4*)(bp + bj * HALF); rb[m][bj][1] = *(const f32x4*)(bp + bj * HALF + 4); } }
            } else {
                u32x4 raw[4][2];
#pragma unroll
                for (int m = 0; m < 4; ++m)
#pragma unroll
                    for (int bj = 0; bj < 2; ++bj) raw[m][bj] = *(const u32x4*)(xb + (size_t)(row0 + ai * HALF + m * 16) * 2048 + col0 + bj * HALF);
#pragma unroll
                for (int m = 0; m < 4; ++m)
#pragma unroll
                    for (int bj = 0; bj < 2; ++bj) { const u32x4 q = raw[m][bj];
                        rb[m][bj][0] = (f32x4){__uint_as_float(q.x << 16), __uint_as_float(q.x & 0xffff0000u), __uint_as_float(q.y << 16), __uint_as_float(q.y & 0xffff0000u)};
                        rb[m][bj][1] = (f32x4){__uint_as_float(q.z << 16), __uint_as_float(q.z & 0xffff0000u), __uint_as_float(q.w << 16), __uint_as_float(q.w & 0xffff0000u)}; }
            }
#pragma unroll
            for (int m = 0; m < 4; ++m) { const int r = row0 + ai * HALF + m * 16; const size_t off = (size_t)r * 2048 + col0; float s = 0.f;
#pragma unroll
                for (int bj = 0; bj < 2; ++bj) { const f32x4 v0 = acc[ai][bj][m][0] + rb[m][bj][0], v1 = acc[ai][bj][m][1] + rb[m][bj][1];
                    s += ((v0[0] * v0[0] + v0[1] * v0[1]) + (v0[2] * v0[2] + v0[3] * v0[3])) + ((v1[0] * v1[0] + v1[1] * v1[1]) + (v1[2] * v1[2] + v1[3] * v1[3]));
                    u32x4 w; w.x = cvt_pk_bf16(v0[0], v0[1]); w.y = cvt_pk_bf16(v0[2], v0[3]); w.z = cvt_pk_bf16(v1[0], v1[1]); w.w = cvt_pk_bf16(v1[2], v1[3]);
                    *(u32x4*)(xo + off + bj * HALF) = w; }
                if (ssq) { s += __shfl_xor(s, 16); s += __shfl_xor(s, 32); if (fq == 0) atomicAdd(ssq + r, s); } }
        }
    }
};
struct EpiMemKV {
    static constexpr bool PERM = false, AFTER_DRAIN = false, KHOOK = false;
    float* pmk; float* pmv; bf16_t* ob;
    __device__ __forceinline__ void operator()(const f32x4 (&acc)[2][2][4][2], const Unit& u, int wr, int wc, int fr, int fq) const {
        const int row0 = u.pm * BM + wr * 64 + fr, col0 = u.pn * BM + wc * 32 + 4 * fq, c512 = (u.pn & 1) * BM + wc * 32 + 4 * fq;
        float* dst = (u.pn < 2) ? pmk : pmv;
#pragma unroll
        for (int ai = 0; ai < 2; ++ai)
#pragma unroll
            for (int m = 0; m < 4; ++m) { const int r = row0 + ai * HALF + m * 16;
#pragma unroll
                for (int bj = 0; bj < 2; ++bj)
#pragma unroll
                    for (int n = 0; n < 2; ++n) { const f32x4 v = acc[ai][bj][m][n];
                        *(f32x4*)(dst + (size_t)r * 512 + c512 + bj * HALF + n * 16) = v;
                        u32x2 w; w.x = cvt_pk_bf16(v[0], v[1]); w.y = cvt_pk_bf16(v[2], v[3]); *(u32x2*)(ob + (size_t)r * 1024 + col0 + bj * HALF + n * 16) = w; } }
    }
};

template <class Epi, class Sched, bool ALIGN_EPI = false, bool SP2 = false>
__device__ __forceinline__ void gemm_phase(PG8_LAS unsigned char* lds, const Gemm g, const Sched& S, const Epi& E) {
    const int tid = threadIdx.x, wid = __builtin_amdgcn_readfirstlane(tid >> 6), lane = tid & 63, wr = wid >> 2, wc = wid & 3, fr = lane & 15, fq = lane >> 4;
    const int K = g.K, ntf = K / BK;
    unsigned voffA[2], voffB[2];
#pragma unroll
    for (int i = 0; i < 2; ++i) { int R, C; stage_rc(tid * 16 + i * 8192, R, C); const int Rb = Epi::PERM ? ((R & ~31) + perm32(R & 31)) : R;
        voffA[i] = (unsigned)(R * K + C) * 2u; voffB[i] = (unsigned)(Rb * K + C) * 2u; }
    const size_t kstep = (size_t)(BK * 2);
    const size_t hstep = (size_t)HALF * K * 2;
    const size_t tstep = 2 * hstep;
    const unsigned ldsw = (unsigned)wid * 1024u;
    const int aoff = lds_byte(wr * 64 + fr, fq * 8), boff = lds_byte(wc * 32 + fr, fq * 8);
#define PG8_SA(b, h) (((b) * 2 + (h)) * HTB)
#define PG8_SB(b, h) ((4 + (b) * 2 + (h)) * HTB)
#define PG8_STAGE(bufoff, gbase, voff) do { _Pragma("unroll") for (int _i = 0; _i < 2; ++_i) \
        __builtin_amdgcn_global_load_lds((const unsigned*)((const char*)(gbase) + (voff)[_i]), (PG8_LAS unsigned*)(lds + (bufoff) + ldsw + _i * 8192), 16, 0, 0); } while (0)
#define PG8_LDA(dst, b, h) do { _Pragma("unroll") for (int m = 0; m < 4; ++m) _Pragma("unroll") for (int k = 0; k < 2; ++k) dst[m][k] = *(const PG8_LAS bf16x8*)(lds + PG8_SA(b, h) + aoff + m * 2048 + k * 1024); } while (0)
#define PG8_LDB(dst, b, h) do { _Pragma("unroll") for (int n = 0; n < 2; ++n) _Pragma("unroll") for (int k = 0; k < 2; ++k) dst[n][k] = *(const PG8_LAS bf16x8*)(lds + PG8_SB(b, h) + boff + n * 2048 + k * 1024); } while (0)
#define PG8_MMA(ai, bj, At, Bt) do { __builtin_amdgcn_s_setprio(1); _Pragma("unroll") for (int m = 0; m < 4; ++m) _Pragma("unroll") for (int n = 0; n < 2; ++n) _Pragma("unroll") for (int k = 0; k < 2; ++k) \
        acc[ai][bj][m][n] = __builtin_amdgcn_mfma_f32_16x16x32_bf16(Bt[n][k], At[m][k], acc[ai][bj][m][n], 0, 0, 0); __builtin_amdgcn_s_setprio(0); } while (0)
#define PG8_WAIT_V(n) asm volatile("s_waitcnt vmcnt(" #n ")" ::: "memory")
#define PG8_WAIT_L(n) asm volatile("s_waitcnt lgkmcnt(" #n ")" ::: "memory")
#define PG8_BAR __builtin_amdgcn_s_barrier()
#define PG8_SCHED __builtin_amdgcn_sched_barrier(0)
    Unit cur, nxt; int ui = 0;
    if (!S.next(0, cur)) return;
    f32x4 acc[2][2][4][2];
#pragma unroll
    for (int a = 0; a < 2; ++a)
#pragma unroll
        for (int b = 0; b < 2; ++b)
#pragma unroll
            for (int m = 0; m < 4; ++m)
#pragma unroll
                for (int n = 0; n < 2; ++n) acc[a][b][m][n] = (f32x4){0.f, 0.f, 0.f, 0.f};
    bf16x8 At[4][2], B0[2][2], B1[2][2];
    const char* cA = (const char*)g.A + (size_t)cur.pm * tstep + (size_t)cur.k0 * kstep; const char* cB = (const char*)g.Bt + (size_t)cur.pn * tstep + (size_t)cur.k0 * kstep;
    int nt = cur.nt ? cur.nt : ntf;
    S.a_ready(cur);
    if constexpr (SP2) {
        PG8_STAGE(PG8_SB(0, 0), cB, voffB); PG8_STAGE(PG8_SB(0, 1), cB + hstep, voffB); PG8_STAGE(PG8_SA(0, 0), cA, voffA); PG8_STAGE(PG8_SA(0, 1), cA + hstep, voffA);
        if (wr == 1) PG8_BAR;
        PG8_WAIT_V(2); PG8_BAR;
        PG8_STAGE(PG8_SB(1, 0), cB + kstep, voffB); PG8_STAGE(PG8_SA(1, 0), cA + kstep, voffA); PG8_STAGE(PG8_SB(1, 1), cB + hstep + kstep, voffB);
        PG8_WAIT_V(6); PG8_BAR;
    } else {
        PG8_STAGE(PG8_SB(0, 0), cB, voffB); PG8_STAGE(PG8_SA(0, 0), cA, voffA); PG8_STAGE(PG8_SB(0, 1), cB + hstep, voffB); PG8_STAGE(PG8_SA(0, 1), cA + hstep, voffA);
        if (wr == 1) PG8_BAR;
        PG8_WAIT_V(4); PG8_BAR;
        PG8_STAGE(PG8_SB(1, 0), cB + kstep, voffB); PG8_STAGE(PG8_SA(1, 0), cA + kstep, voffA); PG8_STAGE(PG8_SB(1, 1), cB + hstep + kstep, voffB);
        PG8_WAIT_V(6); PG8_BAR;
    }
    for (;;) {
        const bool has_next = S.next(ui + 1, nxt);
        const char* nA = has_next ? (const char*)g.A + (size_t)nxt.pm * tstep + (size_t)nxt.k0 * kstep : cA; const char* nB = has_next ? (const char*)g.Bt + (size_t)nxt.pn * tstep + (size_t)nxt.k0 * kstep : cB;
        for (int t = 0; t < nt; t += 2) {
            const bool last = (t == nt - 2);
            const char* a1 = cA + (size_t)(t + 1) * kstep;
            const char* a2 = last ? nA : cA + (size_t)(t + 2) * kstep; const char* b2 = last ? nB : cB + (size_t)(t + 2) * kstep;
            const char* a3 = a2 + kstep; const char* b3 = b2 + kstep;
            if (last && has_next) S.a_ready(nxt);
            if constexpr (Epi::KHOOK) { if (t == 8 || t == 16) E.khook(acc, cur, t, wr, wc, fr, fq); }
            if constexpr (SP2) {
            PG8_LDB(B0, 0, 0); PG8_LDB(B1, 0, 1); PG8_SCHED; PG8_LDA(At, 0, 0); PG8_STAGE(PG8_SA(1, 1), a1 + hstep, voffA);
            PG8_WAIT_V(8); PG8_WAIT_L(0); PG8_BAR; PG8_MMA(0, 0, At, B0); PG8_MMA(0, 1, At, B1); PG8_BAR; PG8_SCHED;
            PG8_LDA(At, 0, 1); PG8_STAGE(PG8_SB(0, 0), b2, voffB); PG8_STAGE(PG8_SB(0, 1), b2 + hstep, voffB); PG8_STAGE(PG8_SA(0, 0), a2, voffA);
            PG8_WAIT_V(8); PG8_WAIT_L(0); PG8_BAR; PG8_MMA(1, 0, At, B0); PG8_MMA(1, 1, At, B1); PG8_BAR; PG8_SCHED;
            PG8_LDB(B0, 1, 0); PG8_LDB(B1, 1, 1); PG8_SCHED; PG8_LDA(At, 1, 0); PG8_STAGE(PG8_SA(0, 1), a2 + hstep, voffA);
            PG8_WAIT_V(8); PG8_WAIT_L(0); PG8_BAR; PG8_MMA(0, 0, At, B0); PG8_MMA(0, 1, At, B1); PG8_BAR; PG8_SCHED;
            PG8_LDA(At, 1, 1); PG8_STAGE(PG8_SB(1, 0), b3, voffB); PG8_STAGE(PG8_SB(1, 1), b3 + hstep, voffB); PG8_STAGE(PG8_SA(1, 0), a3, voffA);
            PG8_WAIT_V(8); PG8_WAIT_L(0); PG8_BAR; PG8_MMA(1, 0, At, B0); PG8_MMA(1, 1, At, B1); PG8_BAR; PG8_SCHED;
            } else {
            PG8_LDB(B0, 0, 0); PG8_SCHED; PG8_LDA(At, 0, 0); PG8_STAGE(PG8_SA(1, 1), a1 + hstep, voffA);
            PG8_WAIT_L(8); PG8_BAR; PG8_WAIT_L(0); PG8_MMA(0, 0, At, B0); PG8_BAR; PG8_SCHED;
            PG8_LDB(B1, 0, 1); PG8_STAGE(PG8_SB(0, 0), b2, voffB);
            PG8_BAR; PG8_WAIT_L(0); PG8_MMA(0, 1, At, B1); PG8_BAR;
            PG8_LDA(At, 0, 1); PG8_STAGE(PG8_SA(0, 0), a2, voffA);
            PG8_BAR; PG8_WAIT_L(0); PG8_MMA(1, 0, At, B0); PG8_BAR; PG8_SCHED;
            PG8_STAGE(PG8_SB(0, 1), b2 + hstep, voffB);
            PG8_WAIT_V(6); PG8_BAR; PG8_MMA(1, 1, At, B1); PG8_BAR;
            PG8_LDB(B0, 1, 0); PG8_SCHED; PG8_LDA(At, 1, 0); PG8_STAGE(PG8_SA(0, 1), a2 + hstep, voffA);
            PG8_WAIT_L(8); PG8_BAR; PG8_WAIT_L(0); PG8_MMA(0, 0, At, B0); PG8_BAR; PG8_SCHED;
            PG8_LDB(B1, 1, 1); PG8_STAGE(PG8_SB(1, 0), b3, voffB);
            PG8_BAR; PG8_WAIT_L(0); PG8_MMA(0, 1, At, B1); PG8_BAR;
            PG8_LDA(At, 1, 1); PG8_STAGE(PG8_SA(1, 0), a3, voffA);
            PG8_BAR; PG8_WAIT_L(0); PG8_MMA(1, 0, At, B0); PG8_BAR; PG8_SCHED;
            PG8_STAGE(PG8_SB(1, 1), b3 + hstep, voffB);
            PG8_WAIT_V(6); PG8_BAR; PG8_MMA(1, 1, At, B1); PG8_BAR;
            }
        }
        if constexpr (ALIGN_EPI) { if (wr == 0) PG8_BAR; }
        if constexpr (!Epi::AFTER_DRAIN) { E(acc, cur, wr, wc, fr, fq); S.done(cur); }
        if (!has_next) break;
#pragma unroll
        for (int a = 0; a < 2; ++a)
#pragma unroll
            for (int b = 0; b < 2; ++b)
#pragma unroll
                for (int m = 0; m < 4; ++m)
#pragma unroll
                    for (int n = 0; n < 2; ++n) acc[a][b][m][n] = (f32x4){0.f, 0.f, 0.f, 0.f};
        cur = nxt; cA = nA; cB = nB; ++ui; nt = cur.nt ? cur.nt : ntf;
        if constexpr (ALIGN_EPI) { if (wr == 1) PG8_BAR; }
    }
    PG8_WAIT_V(0);
    if constexpr (!ALIGN_EPI) { if (wr == 0) PG8_BAR; }
    PG8_BAR;
    if constexpr (Epi::AFTER_DRAIN) { E.fused(acc, cur, wr, wc, fr, fq, lds, wid, lane); S.done(cur); }
#undef PG8_SA
#undef PG8_SB
#undef PG8_STAGE
#undef PG8_LDA
#undef PG8_LDB
#undef PG8_MMA
#undef PG8_WAIT_V
#undef PG8_WAIT_L
#undef PG8_BAR
#undef PG8_SCHED
}
}
#ifndef PG8_SP2
#define PG8_SP2 true
#endif
#ifndef PG8_ALIGN
#define PG8_ALIGN true
#endif
constexpr int NWAVES = 8;
#ifndef MK_ONE_LAUNCH
#define MK_ONE_LAUNCH 1
#endif
constexpr int NPHASE = 13;

constexpr int DM = 2048, SEQ = 2048, NBP = 4, NBS = 128, TS = 4;
constexpr int MP = NBP * SEQ, MS = NBS * TS, M = MP + MS;
constexpr int NMEM = 256, MM = NBP * NMEM;
constexpr int IN_DIM = 3856, NPROJ = 3840;
constexpr int C_Z = 0, C_X = 1024, C_B = 2048, C_C = 2304, C_Q = 2560, C_K = 3584, C_V = 3712;
constexpr int W_DT = 2560;
constexpr int CONVD = 1536, XW = 512, DFF = 5632, NHS = 16, HD = 64, DST = 128, WIN = 128;
constexpr float EPS = 1e-5f;
constexpr int PAST = 16384;
constexpr size_t O_Y = 0, O_PSSM = 17825792, O_PCONV = 18350080, O_PSK = 18368512, O_PSV = 18434048, O_PMK = 18499584, O_PMV = 19023872,
                 O_SSSM = 19548160, O_SCONV = 36325376, O_SSK = 36915200, O_SSV = 39012352, O_END = 41109504;

constexpr size_t MiB = 1u << 20;
constexpr size_t WS_CTL = 0, CTL_ZERO_BYTES = 1 * MiB;
constexpr size_t WS_DT = 1 * MiB;
constexpr size_t WS_ROPE = 2 * MiB;
constexpr size_t WS_CS = 3 * MiB, WS_CD = 3 * MiB + 512 * 1024, WS_SSQH = 4 * MiB;
constexpr size_t WS_WIN = 8 * MiB, WS_WKV = 23 * MiB, WS_WOUT = 27 * MiB, WS_WXQ = 35 * MiB, WS_WXO = 37 * MiB, WS_WGU = 39 * MiB, WS_WDN = 83 * MiB;
constexpr size_t WS_XB = 105 * MiB;
constexpr size_t WS_SLAB = 145 * MiB;
constexpr size_t WS_MN = 139 * MiB;
constexpr size_t WS_MKV = 143 * MiB;
constexpr size_t WS_YATT = 145 * MiB;
constexpr size_t WS_QX = 179 * MiB, WS_OX = 188 * MiB;
constexpr size_t WS_PROJ = 197 * MiB;
constexpr size_t WS_ACT = 197 * MiB;
constexpr size_t WS_HSB = 261 * MiB;
constexpr size_t WS_ST = 291 * MiB;
constexpr size_t WS_XC = 326 * MiB;
constexpr size_t WS_END = 352 * MiB;
constexpr int CW_TMO = 0, CW_CODE = 1;
constexpr int CW_BAR = 4096;
constexpr int CW_SSQ1 = 16384, CW_SSQ2 = CW_SSQ1 + 8704, CW_SSQ3 = CW_SSQ2 + 8704;
static_assert((CW_SSQ3 + 8704) * 4 <= (int)CTL_ZERO_BYTES, "CTL words inside the memset region");

constexpr int RING_OFF = 0, RING_BYTES = 131072;
constexpr int LDS_BYTES = 163840;
constexpr int LDSCTL_OFF = LDS_BYTES - 1024, MISC_OFF = LDSCTL_OFF + 320;
static_assert(MISC_OFF + 128 <= LDS_BYTES, "LDS map");

#define GAS __attribute__((address_space(1)))
#define LAS __attribute__((address_space(3)))
typedef unsigned short bf16;
typedef unsigned v4u __attribute__((ext_vector_type(4)));
typedef float f32x4 __attribute__((ext_vector_type(4)));
typedef short bf16x8 __attribute__((ext_vector_type(8)));
typedef GAS unsigned gu32;
typedef GAS unsigned long long gu64;
#define RLX_AGENT __ATOMIC_RELAXED, __HIP_MEMORY_SCOPE_AGENT
#define LDS_WAIT() asm volatile("s_waitcnt lgkmcnt(0)" ::: "memory")
#define VM_WAIT() asm volatile("s_waitcnt vmcnt(0)" ::: "memory")
__device__ __forceinline__ unsigned long long rt() { return __builtin_amdgcn_s_memrealtime(); }
__device__ __forceinline__ unsigned f2bf(float f) { unsigned u = __builtin_bit_cast(unsigned, f); return (u + 0x7fffu + ((u >> 16) & 1u)) >> 16; }
__device__ __forceinline__ unsigned pk2(float lo, float hi) { return f2bf(lo) | (f2bf(hi) << 16); }

#define XB_TMO      128
#define XB_XCNT(j)  (256  + 64 * (j))
#define XB_XSUB(j)  (1280 + 64 * (j))
#define XB_XGEN(j)  (2304 + 64 * (j))
#define XB_TOP      3328
#define XB_TOPGEN   3392
#define XCD_BAR_WORDS 3456
#define XB_SPIN_CAP (1u << 18)

__device__ __forceinline__ unsigned xb_ld(unsigned* p)              { return __hip_atomic_load(p, __ATOMIC_RELAXED, __HIP_MEMORY_SCOPE_AGENT); }
__device__ __forceinline__ unsigned xb_add(unsigned* p, unsigned v) { return __hip_atomic_fetch_add(p, v, __ATOMIC_RELAXED, __HIP_MEMORY_SCOPE_AGENT); }
__device__ __forceinline__ unsigned xb_xcc_id() { return (unsigned)__builtin_amdgcn_s_getreg((3 << 11) | 20) & 0xFu; }
#define XB_SPIN(cond, bar) do { unsigned _sp = 0; while (cond) { __builtin_amdgcn_s_sleep(1); \
    if ((++_sp & 255u) == 0u) { if (xb_ld(&(bar)[XB_TMO])) break; if (_sp > XB_SPIN_CAP) { atomicAdd(&(bar)[XB_TMO], 1u); break; } } } } while (0)

struct XcdBarrier {
    unsigned* bar; unsigned x;
    volatile LAS unsigned* st;
};

__device__ __forceinline__ XcdBarrier xcd_barrier_post(unsigned* bar, volatile LAS unsigned* st) {
    XcdBarrier b; b.bar = bar; b.x = xb_xcc_id(); b.st = st;
    if (threadIdx.x == 0) (void)xb_add(&bar[XB_XCNT(b.x)], 1u);
    return b;
}
__device__ __forceinline__ void xcd_barrier_complete(unsigned* bar, unsigned x, unsigned& nloc, unsigned& nx) {
    const unsigned G = gridDim.x * gridDim.y * gridDim.z;
    unsigned sum, cnt, mine, sp = 0u;
    for (;;) {
        sum = 0u; cnt = 0u; mine = 0u;
#pragma unroll
        for (unsigned j = 0; j < 16; ++j) { const unsigned c = xb_ld(&bar[XB_XCNT(j)]); sum += c; cnt += (c > 0u) ? 1u : 0u; mine = (j == x) ? c : mine; }
        if (sum == G) break;
        __builtin_amdgcn_s_sleep(1);
        if ((++sp & 255u) == 0u) { if (xb_ld(&bar[XB_TMO])) break; if (sp > XB_SPIN_CAP) { atomicAdd(&bar[XB_TMO], 1u); break; } }
    }
    nloc = mine > 0u ? mine : 1u; nx = cnt > 0u ? cnt : 1u;
}

__device__ __forceinline__ void xcd_barrier(const XcdBarrier& b) {
    asm volatile("s_waitcnt vmcnt(0)" ::: "memory");
    __syncthreads();
    if (threadIdx.x == 0) {
        unsigned* bar = b.bar;
        __builtin_amdgcn_s_waitcnt(0);
        unsigned nloc = b.st[0], nx = b.st[1];
        if (nloc == 0u) { xcd_barrier_complete(bar, b.x, nloc, nx); b.st[0] = nloc; b.st[1] = nx; }
        const unsigned old = xb_add(&bar[XB_XSUB(b.x)], 1u);
        const unsigned gen = old / nloc;
        if (old + 1u == (gen + 1u) * nloc) {
            __builtin_amdgcn_fence(__ATOMIC_RELEASE, "agent");
            asm volatile("s_waitcnt vmcnt(0)" ::: "memory");
            const unsigned og = xb_add(&bar[XB_TOP], 1u);
            const unsigned tg = og / nx;
            if (og + 1u == (tg + 1u) * nx) xb_add(&bar[XB_TOPGEN], 1u);
            else XB_SPIN(xb_ld(&bar[XB_TOPGEN]) == tg, bar);
            __builtin_amdgcn_fence(__ATOMIC_ACQUIRE, "agent");
            xb_add(&bar[XB_XGEN(b.x)], 1u);
            asm volatile("s_waitcnt vmcnt(0)" ::: "memory");
        } else {
            XB_SPIN(xb_ld(&bar[XB_XGEN(b.x)]) == gen, bar);
            __builtin_amdgcn_fence(__ATOMIC_ACQUIRE, "agent");
            asm volatile("s_waitcnt vmcnt(0)" ::: "memory");
        }
    }
    __syncthreads();
}
struct Frame {
    unsigned char* lds;
    LAS unsigned char* ldsl;
    volatile LAS unsigned* MISC;
    gu32* ctl;
    int tid, lane, wave, G, vcu;
    const float* in[30]; float* out; unsigned char* ws;
    __device__ __forceinline__ bf16* Wt_in() const { return (bf16*)(ws + WS_WIN); }
    __device__ __forceinline__ bf16* Wt_kv() const { return (bf16*)(ws + WS_WKV); }
    __device__ __forceinline__ bf16* Wt_out() const { return (bf16*)(ws + WS_WOUT); }
    __device__ __forceinline__ bf16* Wt_xq() const { return (bf16*)(ws + WS_WXQ); }
    __device__ __forceinline__ bf16* Wt_xo() const { return (bf16*)(ws + WS_WXO); }
    __device__ __forceinline__ bf16* Wt_gu() const { return (bf16*)(ws + WS_WGU); }
    __device__ __forceinline__ bf16* Wt_dn() const { return (bf16*)(ws + WS_WDN); }
    __device__ __forceinline__ bf16* XB() const { return (bf16*)(ws + WS_XB); }
    __device__ __forceinline__ bf16* MN() const { return (bf16*)(ws + WS_MN); }
    __device__ __forceinline__ bf16* MKV() const { return (bf16*)(ws + WS_MKV); }
    __device__ __forceinline__ bf16* YATT() const { return (bf16*)(ws + WS_YATT); }
    __device__ __forceinline__ bf16* QX() const { return (bf16*)(ws + WS_QX); }
    __device__ __forceinline__ bf16* OX() const { return (bf16*)(ws + WS_OX); }
    __device__ __forceinline__ bf16* PROJ() const { return (bf16*)(ws + WS_PROJ); }
    __device__ __forceinline__ bf16* ACT() const { return (bf16*)(ws + WS_ACT); }
    __device__ __forceinline__ bf16* XC() const { return (bf16*)(ws + WS_XC); }
    __device__ __forceinline__ bf16* XCT() const { return (bf16*)(ws + WS_XB); }
    __device__ __forceinline__ bf16* HSb() const { return (bf16*)(ws + WS_HSB); }
    __device__ __forceinline__ float* DT() const { return (float*)(ws + WS_DT); }
    __device__ __forceinline__ float* ROPE() const { return (float*)(ws + WS_ROPE); }
    __device__ __forceinline__ float* CS() const { return (float*)(ws + WS_CS); }
    __device__ __forceinline__ float* CD() const { return (float*)(ws + WS_CD); }
    __device__ __forceinline__ float* RG() const { return (float*)(ws + WS_SSQH); }
    __device__ __forceinline__ float* ST() const { return (float*)(ws + WS_ST); }
    __device__ __forceinline__ float* SSQ1() const { return (float*)(ws + WS_CTL) + CW_SSQ1; }
    __device__ __forceinline__ float* SSQ2() const { return (float*)(ws + WS_CTL) + CW_SSQ2; }
    __device__ __forceinline__ float* SSQ3() const { return (float*)(ws + WS_CTL) + CW_SSQ3; }
};
enum { I_XP = 0, I_XS, I_MEM, I_SSSM, I_SCONV, I_CSK, I_CSV, I_CMK, I_CMV, I_NMIX, I_WIN, I_CONVW, I_CONVB, I_DTB, I_ALOG, I_DSKIP, I_GNORM, I_SINKS,
       I_WOUT, I_NMEM, I_NX, I_WXQ, I_WXK, I_WXV, I_WXO, I_NFFN, I_WGATE, I_WUP, I_WDOWN, I_NFINAL };

template <class T> __device__ __forceinline__ T ldnt(const T* p) { return __builtin_nontemporal_load(p); }
template <class T> __device__ __forceinline__ void stnt(T* p, T v) { __builtin_nontemporal_store(v, p); }
__device__ __forceinline__ float bf2f(unsigned u16) { return __uint_as_float(u16 << 16); }
__device__ __forceinline__ void unpack8(const v4u& v, float (&f)[8]) {
    f[0] = __uint_as_float(v.x << 16); f[1] = __uint_as_float(v.x & 0xffff0000u); f[2] = __uint_as_float(v.y << 16); f[3] = __uint_as_float(v.y & 0xffff0000u);
    f[4] = __uint_as_float(v.z << 16); f[5] = __uint_as_float(v.z & 0xffff0000u); f[6] = __uint_as_float(v.w << 16); f[7] = __uint_as_float(v.w & 0xffff0000u);
}
__device__ __forceinline__ v4u pack8(const float (&f)[8]) { v4u o; o.x = pk2(f[0], f[1]); o.y = pk2(f[2], f[3]); o.z = pk2(f[4], f[5]); o.w = pk2(f[6], f[7]); return o; }
__device__ __forceinline__ float wave_sum(float v) {
#pragma unroll
    for (int o = 1; o < 64; o <<= 1) v += __shfl_xor(v, o);
    return v;
}
typedef float f32x2p __attribute__((ext_vector_type(2))); typedef unsigned u32x2p __attribute__((ext_vector_type(2)));
#define LO2(v) __builtin_shufflevector((v), (v), 0, 1)
#define HI2(v) __builtin_shufflevector((v), (v), 2, 3)
#define FMA2(x, y, z) __builtin_elementwise_fma((x), (y), (z))
__device__ __forceinline__ float silu_f(float x) { return x / (1.0f + __expf(-x)); }
__device__ __forceinline__ float silu_r(float x) { return x * __builtin_amdgcn_rcpf(1.0f + __expf(-x)); }

__device__ __forceinline__ void p0_transpose_item(const float* W, int ldw, int col0, int K, int N, bf16* WT, int mode, int rowoff, const float* ks, int kslim, float* scr, int item, int lane) {
    const int nblk = N / 64, kb = item / nblk, nb = item % nblk, k0 = 64 * kb, n0 = 64 * nb;
    const int n4 = lane & 15, kr = lane >> 4;
    f32x4 v[16];
#pragma unroll
    for (int i = 0; i < 16; ++i) { const int kk = 4 * i + kr; v[i] = ldnt((const f32x4*)(W + (size_t)(k0 + kk) * ldw + col0 + n0 + 4 * n4)); }
    float kv[16];
    if (ks) {
#pragma unroll
        for (int i = 0; i < 16; ++i) { const int k = k0 + 4 * i + kr; kv[i] = ks[k < kslim ? k : 0]; }
#pragma unroll
        for (int i = 0; i < 16; ++i) { const int k = k0 + 4 * i + kr; kv[i] = (k < kslim) ? kv[i] : 1.0f; }
    } else {
#pragma unroll
        for (int i = 0; i < 16; ++i) kv[i] = 1.0f; }
#pragma unroll
    for (int i = 0; i < 16; ++i) { const int kk = 4 * i + kr; *(f32x4*)(scr + kk * 64 + 4 * (n4 ^ ((kk >> 3) & 7))) = v[i] * kv[i]; }
    LDS_WAIT(); asm volatile("" ::: "memory");
    const int c = lane & 7;
#pragma unroll
    for (int j = 0; j < 8; ++j) { const int n = (lane >> 3) + 8 * j; const float* s = scr + (8 * c) * 64 + (n ^ (4 * c)); const int nn = n0 + n;
        const int drow = (mode == 0) ? rowoff + nn : 256 * (nn >> 7) + (nn & 127) + rowoff;
        v4u o; o.x = pg8::cvt_pk_bf16(s[0 * 64], s[1 * 64]); o.y = pg8::cvt_pk_bf16(s[2 * 64], s[3 * 64]); o.z = pg8::cvt_pk_bf16(s[4 * 64], s[5 * 64]); o.w = pg8::cvt_pk_bf16(s[6 * 64], s[7 * 64]);
        *(v4u*)(WT + (size_t)drow * K + k0 + 8 * c) = o; }
    LDS_WAIT(); asm volatile("" ::: "memory");
}
__device__ __forceinline__ void p0_prologue(Frame& F, int parts = 7) {
    const int gw = blockIdx.x * NWAVES + F.wave, NGW = F.G * NWAVES;
    float* scr = (float*)(F.lds + RING_OFF + F.wave * 16384);
    constexpr int I0 = 32 * 40, I1 = 32 * 20, I2 = 256, I3 = 256, I4 = 1024, I5 = 256, I6 = 256, I7 = 2816, I8 = 2816, I9 = 2816;
    constexpr int NITEMS = I0 + I1 + I4;
    if (parts & 1) for (int it = gw; it < NITEMS; it += NGW) {
        int r = it;
        if (r < I0) { p0_transpose_item(F.in[I_WIN], IN_DIM, 0, DM, 2560, F.Wt_in(), 0, 0, nullptr, 0, scr, r, F.lane); continue; } r -= I0;
        if (r < I1) { p0_transpose_item(F.in[I_WIN], IN_DIM, 2576, DM, 1280, F.Wt_in(), 0, 2560, nullptr, 0, scr, r, F.lane); continue; } r -= I1;
        p0_transpose_item(F.in[I_WOUT], DM, 0, DM, DM, F.Wt_out(), 0, 0, F.in[I_GNORM], 1024, scr, r, F.lane);
    }
    const bool g256 = (F.G == 256);
    if (parts & 2) for (int e = (g256 ? ((int)blockIdx.x >= 208 ? (int)blockIdx.x - 208 : (int)blockIdx.x + 48) : (int)blockIdx.x) * 512 + F.tid; e < 2052 * 8; e += F.G * 512) {
        const int idx = e >> 3, i = e & 7; const double pos = (double)(idx < 2048 ? idx : PAST + idx - 2048);
        const double ang = pos * pow(500000.0, -(double)i / 8.0);
        F.ROPE()[2 * e] = (float)cos(ang); F.ROPE()[2 * e + 1] = (float)sin(ang);
    }
    __syncthreads();
    float* wdt = (float*)(F.lds + RING_OFF);
#pragma unroll 16
    for (int e = F.tid; e < 4 * DM; e += 512) { const int k = e >> 2, q = e & 3; const f32x4 w4 = *(const f32x4*)(F.in[I_WIN] + (size_t)k * IN_DIM + W_DT + 4 * q);
        wdt[(4 * q) * DM + k] = w4.x; wdt[(4 * q + 1) * DM + k] = w4.y; wdt[(4 * q + 2) * DM + k] = w4.z; wdt[(4 * q + 3) * DM + k] = w4.w; }
    float* gL = wdt + 16 * DM;
    for (int e = F.tid; e < 2 * DM / 4; e += 512) ((f32x4*)gL)[e] = (e < DM / 4) ? ((const f32x4*)F.in[I_NMIX])[e] : ((const f32x4*)F.in[I_NMEM])[e - DM / 4];
    __syncthreads();
    constexpr int NPAIR = (M + MM) / 2;
    const int third = 2 * NGW + ((int)blockIdx.x - 112) * NWAVES + F.wave;
    const bool has3 = g256 && (int)blockIdx.x >= 112 && third < NPAIR;
    const int npair = (parts & 4) ? (g256 ? (has3 ? 3 : 2) : (NPAIR - gw + NGW - 1) / NGW) : 0;
#define P0_PIDX(i_) ((g256 && (i_) == 2) ? third : gw + (i_) * NGW)
#define P0_ROWPTR(pr_) ((2 * (pr_)) >= M ? F.in[I_MEM] + (size_t)(2 * (pr_) - M) * DM : ((2 * (pr_)) < MP ? F.in[I_XP] + (size_t)(2 * (pr_)) * DM : F.in[I_XS] + (size_t)(2 * (pr_) - MP) * DM))
#define P0_LOAD(pr_, a_, b_) do { const f32x4* xr_ = (const f32x4*)(P0_ROWPTR(pr_)) + F.lane; _Pragma("unroll") for (int j = 0; j < 8; ++j) { a_[j] = ldnt(xr_ + 64 * j); b_[j] = ldnt(xr_ + 512 + 64 * j); } } while (0)
    f32x4 a[8], b[8];
    if (npair > 0) P0_LOAD(P0_PIDX(0), a, b);
#pragma unroll 1
    for (int i = 0; i < npair; ++i) {
        const int pr = P0_PIDX(i), m = 2 * pr; const bool ismem = m >= M, more = (i + 1) < npair;
        f32x4 na[8], nb[8];
        { const int pn = more ? P0_PIDX(i + 1) : pr; P0_LOAD(pn, na, nb); }
        const LAS f32x4* gr = (const LAS f32x4*)(F.ldsl + RING_OFF + (16 + (ismem ? 1 : 0)) * DM * 4) + F.lane;
        f32x2p q0 = {0.f, 0.f}, q1 = {0.f, 0.f};
#pragma unroll
        for (int j = 0; j < 8; ++j) { q0 = FMA2(LO2(a[j]), LO2(a[j]), q0); q0 = FMA2(HI2(a[j]), HI2(a[j]), q0); q1 = FMA2(LO2(b[j]), LO2(b[j]), q1); q1 = FMA2(HI2(b[j]), HI2(b[j]), q1); }
        const float r0 = 1.0f / sqrtf(wave_sum(q0.x + q0.y) * (1.0f / DM) + EPS), r1 = 1.0f / sqrtf(wave_sum(q1.x + q1.y) * (1.0f / DM) + EPS);
#pragma unroll
        for (int j = 0; j < 8; ++j) { const f32x4 g = gr[64 * j]; a[j] = a[j] * (g * r0); b[j] = b[j] * (g * r1); }
        bf16* orow = ismem ? F.MN() + (size_t)(m - M) * DM : F.XB() + (size_t)m * DM;
        u32x2p* o8 = (u32x2p*)orow + F.lane;
#pragma unroll
        for (int j = 0; j < 8; ++j) { u32x2p wa, wb; wa.x = pg8::cvt_pk_bf16(a[j].x, a[j].y); wa.y = pg8::cvt_pk_bf16(a[j].z, a[j].w); wb.x = pg8::cvt_pk_bf16(b[j].x, b[j].y); wb.y = pg8::cvt_pk_bf16(b[j].z, b[j].w);
                                      o8[64 * j] = wa; o8[512 + 64 * j] = wb; }
        if (!ismem && !(parts & 8)) {
            float P[32];
            unsigned wo = 16u * F.lane; asm volatile("" : "+v"(wo));
            const LAS float* wl = (const LAS float*)(F.ldsl + RING_OFF + wo);
#pragma unroll
            for (int h = 0; h < 16; ++h) { f32x2p c0 = {0.f, 0.f}, c1 = {0.f, 0.f};
#pragma unroll
                for (int j = 0; j < 8; ++j) { const f32x4 w = *(const LAS f32x4*)(wl + h * DM + 256 * j);
                    c0 = FMA2(LO2(a[j]), LO2(w), c0); c1 = FMA2(LO2(b[j]), LO2(w), c1); c0 = FMA2(HI2(a[j]), HI2(w), c0); c1 = FMA2(HI2(b[j]), HI2(w), c1); }
                P[h] = c0.x + c0.y; P[16 + h] = c1.x + c1.y; if (h & 1) __builtin_amdgcn_sched_barrier(0); }
#pragma unroll
            for (int st = 0; st < 5; ++st) { const int half = 16 >> st; const bool up = (F.lane >> st) & 1;
#pragma unroll
                for (int q = 0; q < 16; ++q) if (q < half) { float x = P[q], y = P[q + half]; asm volatile("" : "+v"(x), "+v"(y));
                    const float keep = up ? y : x, send = up ? x : y; P[q] = keep + __shfl_xor(send, 1 << st); } }
            const float tot = P[0] + __shfl_xor(P[0], 32);
            if (F.lane < 32) { const int l = F.lane, rr = l & 1, h = (((l >> 1) & 1) << 3) | (((l >> 2) & 1) << 2) | (((l >> 3) & 1) << 1) | ((l >> 4) & 1);
                const float xx = tot + F.in[I_DTB][h]; F.DT()[(size_t)(m + rr) * 16 + h] = xx > 20.f ? xx : log1pf(__expf(xx)); }
        }
#pragma unroll
        for (int j = 0; j < 8; ++j) { a[j] = na[j]; b[j] = nb[j]; }
    }
#undef P0_PIDX
#undef P0_ROWPTR
#undef P0_LOAD
}


__device__ __forceinline__ void xattn_weight_copies(Frame& F, int cu0, int cu1) {
    if ((int)blockIdx.x < cu0 || (int)blockIdx.x >= cu1) return;
    const int gw = ((int)blockIdx.x - cu0) * NWAVES + F.wave, NGW = (cu1 - cu0) * NWAVES;
    float* scr = (float*)(F.lds + RING_OFF + F.wave * 16384);
    for (int it = gw; it < 1024; it += NGW) { const int r = it & 255;
        if (it < 256) p0_transpose_item(F.in[I_WXK], XW, 0, DM, XW, F.Wt_kv(), 0, 0, nullptr, 0, scr, r, F.lane);
        else if (it < 512) p0_transpose_item(F.in[I_WXV], XW, 0, DM, XW, F.Wt_kv(), 0, 512, nullptr, 0, scr, r, F.lane);
        else if (it < 768) p0_transpose_item(F.in[I_WXQ], XW, 0, DM, XW, F.Wt_xq(), 0, 0, F.in[I_NX], 1 << 30, scr, r, F.lane);
        else p0_transpose_item(F.in[I_WXO], DM, 0, XW, DM, F.Wt_xo(), 0, 0, nullptr, 0, scr, r, F.lane); }
}
__device__ __forceinline__ void ffn_weight_copies(Frame& F, int which, int cu0, int cu1) {
    if ((int)blockIdx.x < cu0 || (int)blockIdx.x >= cu1) return;
    const int gw = ((int)blockIdx.x - cu0) * NWAVES + F.wave, NGW = (cu1 - cu0) * NWAVES;
    float* scr = (float*)(F.lds + RING_OFF + F.wave * 16384);
    if (which == 0) { for (int it = gw; it < 2 * 2816; it += NGW) { if (it < 2816) p0_transpose_item(F.in[I_WGATE], DFF, 0, DM, DFF, F.Wt_gu(), 1, 0, F.in[I_NFFN], 1 << 30, scr, it, F.lane);
                                                                   else p0_transpose_item(F.in[I_WUP], DFF, 0, DM, DFF, F.Wt_gu(), 1, 128, F.in[I_NFFN], 1 << 30, scr, it - 2816, F.lane); } }
    else { for (int it = gw; it < 2816; it += NGW) p0_transpose_item(F.in[I_WDOWN], DM, 0, DFF, DM, F.Wt_dn(), 0, 0, nullptr, 0, scr, it, F.lane); }
}
typedef float f32x16 __attribute__((ext_vector_type(16)));
typedef unsigned u32x2v __attribute__((ext_vector_type(2)));
typedef unsigned u32x4 __attribute__((ext_vector_type(4)));
#define MFMA32(a, b, c) __builtin_amdgcn_mfma_f32_32x32x16_bf16((a), (b), (c), 0, 0, 0)
__device__ __forceinline__ v4u pack8c(const float (&f)[8]) { v4u o; o.x = pg8::cvt_pk_bf16(f[0], f[1]); o.y = pg8::cvt_pk_bf16(f[2], f[3]); o.z = pg8::cvt_pk_bf16(f[4], f[5]); o.w = pg8::cvt_pk_bf16(f[6], f[7]); return o; }
constexpr int LP = 136;

template <bool SAMP>
__device__ __forceinline__ void conv_loop(Frame& F) {
    bf16* T = (bf16*)(F.lds + RING_OFF); constexpr int TP = 136;
    const int quad = F.tid >> 4, c8 = F.tid & 15;
    constexpr int IT0 = SAMP ? 64 * 12 : 0, IT1 = SAMP ? 68 * 12 : 64 * 12;
#define CONV_LOAD(it_, raw_) do { const int m_ = ((it_) / 12) * 128 + 4 * quad, ch_ = ((it_) % 12) * 128 + c8 * 8; const bool has_ = !SAMP && ((m_ & 2047) > 0); \
        _Pragma("unroll") for (int j = 0; j < 7; ++j) raw_[j] = *(const v4u*)(F.PROJ() + (size_t)((j >= 3 || has_) ? m_ - 3 + j : m_) * NPROJ + C_X + ch_); } while (0)
    int it = IT0 + blockIdx.x; v4u cur[7], nxt[7];
    if (it < IT1) CONV_LOAD(it, cur);
#pragma unroll 1
    for (; it < IT1; it += F.G) {
        const int tb = it / 12, cb = it % 12, m0 = tb * 128, ch0 = cb * 128, ch = ch0 + c8 * 8; const bool tr = !SAMP && (ch0 < 1280);
        const int m = m0 + 4 * quad; const int t = SAMP ? 0 : (m & 2047);
        f32x4 wv[5][2], sv[3][2];
        { const float* bp_ = F.in[I_CONVB] + ch; wv[4][0] = *(const f32x4*)bp_; wv[4][1] = *(const f32x4*)(bp_ + 4);
#pragma unroll
          for (int k = 0; k < 4; ++k) { const float* wp = F.in[I_CONVW] + (size_t)k * CONVD + ch; wv[k][0] = *(const f32x4*)wp; wv[k][1] = *(const f32x4*)(wp + 4); }
          if constexpr (SAMP) {
#pragma unroll
              for (int j = 0; j < 3; ++j) { const float* sp = F.in[I_SCONV] + ((size_t)((m - MP) >> 2) * 3 + j) * CONVD + ch; sv[j][0] = *(const f32x4*)sp; sv[j][1] = *(const f32x4*)(sp + 4); } } }
        __builtin_amdgcn_sched_barrier(0);
        { const int itn = (it + F.G < IT1) ? it + F.G : it; CONV_LOAD(itn, nxt); }
        __builtin_amdgcn_sched_barrier(0);
        f32x2p r[7][4];
#pragma unroll
        for (int j = 0; j < 7; ++j) {
            if (j >= 3 || !SAMP) { const v4u q = cur[j]; const unsigned qq[4] = {q.x, q.y, q.z, q.w};
#pragma unroll
                for (int e2 = 0; e2 < 4; ++e2) { r[j][e2] = (f32x2p){__uint_as_float(qq[e2] << 16), __uint_as_float(qq[e2] & 0xffff0000u)}; if (!SAMP && j < 3) r[j][e2] = (t > 0) ? r[j][e2] : (f32x2p){0.f, 0.f}; } }
            else { r[j][0] = LO2(sv[j < 3 ? j : 0][0]); r[j][1] = HI2(sv[j < 3 ? j : 0][0]); r[j][2] = LO2(sv[j < 3 ? j : 0][1]); r[j][3] = HI2(sv[j < 3 ? j : 0][1]); } }
        f32x2p o2[4][4];
#pragma unroll
        for (int i = 0; i < 4; ++i) { o2[i][0] = LO2(wv[4][0]); o2[i][1] = HI2(wv[4][0]); o2[i][2] = LO2(wv[4][1]); o2[i][3] = HI2(wv[4][1]); }
#pragma unroll
        for (int k = 0; k < 4; ++k) { const f32x2p w2[4] = {LO2(wv[k][0]), HI2(wv[k][0]), LO2(wv[k][1]), HI2(wv[k][1])};
#pragma unroll
            for (int i = 0; i < 4; ++i)
#pragma unroll
                for (int e2 = 0; e2 < 4; ++e2) o2[i][e2] = FMA2(w2[e2], r[i + k][e2], o2[i][e2]); }
        float o[4][8];
#pragma unroll
        for (int i = 0; i < 4; ++i)
#pragma unroll
            for (int e2 = 0; e2 < 4; ++e2) { o[i][2 * e2] = silu_r(o2[i][e2].x); o[i][2 * e2 + 1] = silu_r(o2[i][e2].y); }
        if (SAMP || ch0 >= 1024) {
#pragma unroll
            for (int i = 0; i < 4; ++i) *(v4u*)(F.XC() + (size_t)(m + i) * CONVD + ch) = pack8c(o[i]); }
        __syncthreads();
        if (tr) {
#pragma unroll
            for (int e = 0; e < 8; ++e) { u32x2v w; w.x = pg8::cvt_pk_bf16(o[0][e], o[1][e]); w.y = pg8::cvt_pk_bf16(o[2][e], o[3][e]); *(u32x2v*)(T + (c8 * 8 + e) * TP + 4 * quad) = w; }
            __syncthreads();
#pragma unroll
            for (int j = 0; j < 4; ++j) { const int idx = F.tid + 512 * j, chl = idx >> 4, t16 = idx & 15;
                *(v4u*)(F.XCT() + (size_t)(ch0 + chl) * MP + m0 + t16 * 8) = *(const v4u*)(T + chl * TP + t16 * 8); } }
#pragma unroll
        for (int j = 0; j < 7; ++j) cur[j] = nxt[j];
    }
#undef CONV_LOAD
}
__device__ __forceinline__ void conv_phase(Frame& F) { conv_loop<false>(F); conv_loop<true>(F); }

__device__ __forceinline__ void ssd_s1_item(Frame& F, int b, int c, int g, int pb) {
    const int m0 = b * SEQ + c * 128, w = F.wave, head = 8 * g + w, lane = F.lane, r = lane & 31, h = lane >> 5;
    bf16* BT = (bf16*)(F.lds + RING_OFF);
    float* wL = (float*)(F.lds + RING_OFF + 128 * LP * 2);
    __syncthreads();
#pragma unroll
    for (int i = 0; i < 4; ++i) { const int idx = F.tid + 512 * i, n = idx >> 4, c16 = idx & 15;
        *(v4u*)(BT + n * LP + c16 * 8) = *(const v4u*)(F.XCT() + (size_t)(1024 + g * 128 + n) * MP + m0 + c16 * 8); }
    const float a = -__expf(F.in[I_ALOG][head]);
    const float dt0 = F.DT()[(size_t)(m0 + lane) * 16 + head], dt1 = F.DT()[(size_t)(m0 + 64 + lane) * 16 + head];
    float p0 = dt0 * a, p1 = dt1 * a;
#pragma unroll
    for (int o = 1; o < 64; o <<= 1) { const float t0 = __shfl_up(p0, o), t1 = __shfl_up(p1, o); if (lane >= o) { p0 += t0; p1 += t1; } }
    p1 += __shfl(p0, 63); const float cend = __shfl(p1, 63);
    if (pb == 0) { F.CS()[(size_t)(m0 + lane) * 16 + head] = p0; F.CS()[(size_t)(m0 + 64 + lane) * 16 + head] = p1; if (lane == 0) F.CD()[(b * 16 + head) * 16 + c] = __expf(cend); }
    wL[w * 128 + lane] = __expf(cend - p0) * dt0; wL[w * 128 + 64 + lane] = __expf(cend - p1) * dt1;
    __syncthreads();
    f32x16 acc[4];
#pragma unroll
    for (int nb = 0; nb < 4; ++nb)
#pragma unroll
        for (int i = 0; i < 16; ++i) acc[nb][i] = 0.f;
    const bf16* xrow = F.XCT() + (size_t)(head * 64 + 32 * pb + r) * MP + m0 + 8 * h;
#pragma unroll
    for (int ks = 0; ks < 8; ++ks) {
        const f32x4 w0 = *(const f32x4*)(wL + w * 128 + 16 * ks + 8 * h), w1 = *(const f32x4*)(wL + w * 128 + 16 * ks + 8 * h + 4);
        float f[8]; unpack8(*(const v4u*)(xrow + 16 * ks), f);
        f[0] *= w0.x; f[1] *= w0.y; f[2] *= w0.z; f[3] *= w0.w; f[4] *= w1.x; f[5] *= w1.y; f[6] *= w1.z; f[7] *= w1.w;
        const bf16x8 A = __builtin_bit_cast(bf16x8, pack8c(f));
#pragma unroll
        for (int nb = 0; nb < 4; ++nb) { const bf16x8 Bf = *(const bf16x8*)(BT + (32 * nb + r) * LP + 16 * ks + 8 * h); acc[nb] = MFMA32(A, Bf, acc[nb]); }
    }
    bf16* st = (bf16*)F.ST() + ((size_t)(b * 16 + head) * 16 + c) * 8192;
#pragma unroll
    for (int nb = 0; nb < 4; ++nb)
#pragma unroll
        for (int i = 0; i < 16; ++i) st[(32 * pb + (i & 3) + 8 * (i >> 2) + 4 * h) * 128 + 32 * nb + r] = (bf16)(pg8::cvt_pk_bf16(acc[nb][i], 0.f) & 0xffffu);
}

__device__ __forceinline__ void ssd_s2_phase(Frame& F) {
    for (int tg = blockIdx.x * 512 + F.tid; tg < 64 * 2048; tg += F.G * 512) {
        const int bh = tg >> 11, e4 = tg & 2047; const bf16* base = (const bf16*)F.ST() + (size_t)bh * 16 * 8192 + 4 * e4;
        u32x2v q[16]; float d[16];
#pragma unroll
        for (int c = 0; c < 16; ++c) q[c] = *(const u32x2v*)(base + (size_t)c * 8192);
#pragma unroll
        for (int c = 0; c < 16; ++c) d[c] = F.CD()[bh * 16 + c];
        __builtin_amdgcn_sched_barrier(0);
        f32x4 hh = {0.f, 0.f, 0.f, 0.f};
#pragma unroll
        for (int c = 0; c < 16; ++c) { u32x2v o; o.x = pg8::cvt_pk_bf16(hh.x, hh.y); o.y = pg8::cvt_pk_bf16(hh.z, hh.w);
            *(u32x2v*)(F.HSb() + ((size_t)bh * 16 + c) * 8192 + 4 * e4) = o;
            const f32x4 sc = {__uint_as_float(q[c].x << 16), __uint_as_float(q[c].x & 0xffff0000u), __uint_as_float(q[c].y << 16), __uint_as_float(q[c].y & 0xffff0000u)};
            hh = hh * d[c] + sc; }
        *(f32x4*)(F.out + O_PSSM + (size_t)bh * 8192 + 4 * e4) = hh;
    }
}

__device__ __forceinline__ void ssd_sample_item(Frame& F, int b, int head, float* ssqL) {
    const int lane = F.lane, pl = lane >> 3, nl = lane & 7, n0 = 4 * nl, g = head >> 3;
    const float a = -__expf(F.in[I_ALOG][head]), Dk = F.in[I_DSKIP][head];
    const float* h0 = F.in[I_SSSM] + (size_t)(b * 16 + head) * 8192; float* ho = F.out + O_SSSM + (size_t)(b * 16 + head) * 8192;
    f32x4 sa[4], sb[4], sc[4];
#pragma unroll
    for (int i = 0; i < 4; ++i) { sa[i] = ldnt((const f32x4*)(h0 + (size_t)(pl) * 128 + n0 + 32 * i)); sb[i] = ldnt((const f32x4*)(h0 + (size_t)(8 + pl) * 128 + n0 + 32 * i)); sc[i] = ldnt((const f32x4*)(h0 + (size_t)(16 + pl) * 128 + n0 + 32 * i)); }
    float dtv[4], dec[4]; u32x2v Bp[4][4], Cp[4][4];
    float* xzL = ssqL + 64 + F.wave * 512;
#pragma unroll
    for (int t = 0; t < 4; ++t) { const size_t m = (size_t)MP + 4 * b + t; dtv[t] = F.DT()[m * 16 + head];
        const bf16* br = F.XC() + m * CONVD + 1024 + g * 128 + n0; const bf16* cr = F.XC() + m * CONVD + 1280 + g * 128 + n0;
#pragma unroll
        for (int i = 0; i < 4; ++i) { Bp[t][i] = *(const u32x2v*)(br + 32 * i); Cp[t][i] = *(const u32x2v*)(cr + 32 * i); }
        xzL[t * 64 + lane] = bf2f(F.XC()[m * CONVD + head * 64 + lane]); xzL[256 + t * 64 + lane] = bf2f(F.PROJ()[m * NPROJ + C_Z + head * 64 + lane]); }
#pragma unroll
    for (int t = 0; t < 4; ++t) dec[t] = __expf(dtv[t] * a);
    asm volatile("s_waitcnt lgkmcnt(0)" ::: "memory"); __builtin_amdgcn_wave_barrier();
    float ssq[4] = {0.f, 0.f, 0.f, 0.f};
#pragma unroll 1
    for (int pass = 0; pass < 8; ++pass) {
        const int p = 8 * pass + pl; float hh[16];
#pragma unroll
        for (int i = 0; i < 4; ++i) { hh[4 * i] = sa[i].x; hh[4 * i + 1] = sa[i].y; hh[4 * i + 2] = sa[i].z; hh[4 * i + 3] = sa[i].w; sa[i] = sb[i]; sb[i] = sc[i]; }
        if (pass < 5) {
#pragma unroll
            for (int i = 0; i < 4; ++i) sc[i] = ldnt((const f32x4*)(h0 + (size_t)(p + 24) * 128 + n0 + 32 * i)); }
#pragma unroll
        for (int t = 0; t < 4; ++t) { const size_t m = (size_t)MP + 4 * b + t;
            const float xv = xzL[t * 64 + p], z = xzL[256 + t * 64 + p], xdt = xv * dtv[t];
            asm volatile("" : "+v"(Bp[t][0]), "+v"(Bp[t][1]), "+v"(Bp[t][2]), "+v"(Bp[t][3]), "+v"(Cp[t][0]), "+v"(Cp[t][1]), "+v"(Cp[t][2]), "+v"(Cp[t][3]));
            float yp = 0.f;
#pragma unroll
            for (int i = 0; i < 4; ++i) { const u32x2v bq = Bp[t][i], cq = Cp[t][i];
                const float b0 = __uint_as_float(bq.x << 16), b1 = __uint_as_float(bq.x & 0xffff0000u), b2 = __uint_as_float(bq.y << 16), b3 = __uint_as_float(bq.y & 0xffff0000u);
                const float c0 = __uint_as_float(cq.x << 16), c1 = __uint_as_float(cq.x & 0xffff0000u), c2 = __uint_as_float(cq.y << 16), c3 = __uint_as_float(cq.y & 0xffff0000u);
                hh[4 * i] = hh[4 * i] * dec[t] + xdt * b0; hh[4 * i + 1] = hh[4 * i + 1] * dec[t] + xdt * b1; hh[4 * i + 2] = hh[4 * i + 2] * dec[t] + xdt * b2; hh[4 * i + 3] = hh[4 * i + 3] * dec[t] + xdt * b3;
                yp += (c0 * hh[4 * i] + c1 * hh[4 * i + 1]) + (c2 * hh[4 * i + 2] + c3 * hh[4 * i + 3]); }
            yp += __shfl_xor(yp, 1); yp += __shfl_xor(yp, 2); yp += __shfl_xor(yp, 4);
            const float v = (yp + Dk * xv) * silu_f(z);
            if (nl == 0) { F.YATT()[m * DM + head * 64 + p] = (bf16)f2bf(v); ssq[t] += v * v; }
        }
#pragma unroll
        for (int i = 0; i < 4; ++i) { f32x4 v; v.x = hh[4 * i]; v.y = hh[4 * i + 1]; v.z = hh[4 * i + 2]; v.w = hh[4 * i + 3]; stnt((f32x4*)(ho + (size_t)p * 128 + n0 + 32 * i), v); }
    }
#pragma unroll
    for (int t = 0; t < 4; ++t) { float s = ssq[t]; s += __shfl_xor(s, 8); s += __shfl_xor(s, 16); s += __shfl_xor(s, 32); if (lane == 0) ssqL[F.wave * 4 + t] = s; }
}

template <int TB>
__device__ __forceinline__ void s3_wfrags(const bf16* Bn, const bf16* Cn, const float* csw, const float* dtw, int lane, bf16x8 (&Cf)[8], bf16x8 (&Wf)[TB + 1][2]) {
    const int r = lane & 31, h = lane >> 5, t = 32 * TB + r; const float cs_t = csw[t];
#pragma unroll
    for (int ks = 0; ks < 8; ++ks) Cf[ks] = *(const bf16x8*)(Cn + t * LP + 16 * ks + 8 * h);
#pragma unroll
    for (int sb = 0; sb <= TB; ++sb) {
        f32x16 X;
#pragma unroll
        for (int i = 0; i < 16; ++i) X[i] = 0.f;
#pragma unroll
        for (int ks = 0; ks < 8; ++ks) { const bf16x8 A = *(const bf16x8*)(Bn + (32 * sb + r) * LP + 16 * ks + 8 * h); X = MFMA32(A, Cf[ks], X); }
        float e[16];
#pragma unroll
        for (int g4 = 0; g4 < 4; ++g4) { const int s0 = 32 * sb + 8 * g4 + 4 * h; const f32x4 cs4 = *(const f32x4*)(csw + s0), dt4 = *(const f32x4*)(dtw + s0);
#pragma unroll
            for (int k = 0; k < 4; ++k) { const float ev = __expf(cs_t - cs4[k]) * dt4[k]; e[4 * g4 + k] = (sb < TB || (s0 + k) <= t) ? X[4 * g4 + k] * ev : 0.f; } }
        u32x4 w0, w1;
        w0.x = pg8::cvt_pk_bf16(e[0], e[1]); w0.y = pg8::cvt_pk_bf16(e[2], e[3]); w0.z = pg8::cvt_pk_bf16(e[4], e[5]); w0.w = pg8::cvt_pk_bf16(e[6], e[7]);
        w1.x = pg8::cvt_pk_bf16(e[8], e[9]); w1.y = pg8::cvt_pk_bf16(e[10], e[11]); w1.z = pg8::cvt_pk_bf16(e[12], e[13]); w1.w = pg8::cvt_pk_bf16(e[14], e[15]);
        Wf[sb][0] = __builtin_bit_cast(bf16x8, w0); Wf[sb][1] = __builtin_bit_cast(bf16x8, w1);
    }
}
template <int TB>
__device__ __forceinline__ void s3_ymma(const bf16* XT, const bf16x8 (&Wf)[TB + 1][2], int lane, f32x16& y, unsigned (&xs)[8]) {
    const int r = lane & 31, h = lane >> 5, t = 32 * TB + r;
#pragma unroll
    for (int i = 0; i < 16; ++i) y[i] = 0.f;
    const bf16* xr = XT + r * LP + 4 * h;
#pragma unroll
    for (int sb = 0; sb <= TB; ++sb)
#pragma unroll
        for (int s2 = 0; s2 < 2; ++s2) { const u32x2v lo = *(const u32x2v*)(xr + 32 * sb + 16 * s2), hi = *(const u32x2v*)(xr + 32 * sb + 16 * s2 + 8);
            u32x4 av; av.x = lo.x; av.y = lo.y; av.z = hi.x; av.w = hi.y; y = MFMA32(__builtin_bit_cast(bf16x8, av), Wf[sb][s2], y); }
#pragma unroll
    for (int i = 0; i < 4; ++i)
#pragma unroll
        for (int k = 0; k < 2; ++k) xs[2 * i + k] = (unsigned)XT[(8 * i + 4 * h + 2 * k) * LP + t] | ((unsigned)XT[(8 * i + 4 * h + 2 * k + 1) * LP + t] << 16);
}
template <int TB>
__device__ __forceinline__ void s3_fin(Frame& F, const bf16* HT, const bf16* Cn, const f32x16& y, const unsigned (&xs)[8], float ecs, const u32x2v (&zg)[4], size_t m, int head, int pb, float Dk, float& ssq) {
    const int lane = F.lane, r = lane & 31, h = lane >> 5, t = 32 * TB + r;
    f32x16 yo;
#pragma unroll
    for (int i = 0; i < 16; ++i) yo[i] = 0.f;
    const bf16* hr = HT + r * LP + 8 * h;
#pragma unroll
    for (int ks = 0; ks < 8; ++ks) { const bf16x8 A = *(const bf16x8*)(hr + 16 * ks), Cfk = *(const bf16x8*)(Cn + t * LP + 16 * ks + 8 * h); yo = MFMA32(A, Cfk, yo); }
#pragma unroll
    for (int i = 0; i < 4; ++i) { const int p0 = 32 * pb + 8 * i + 4 * h; const u32x2v zq = zg[i];
        const float z0 = __uint_as_float(zq.x << 16), z1 = __uint_as_float(zq.x & 0xffff0000u), z2 = __uint_as_float(zq.y << 16), z3 = __uint_as_float(zq.y & 0xffff0000u);
        const float x0 = __uint_as_float(xs[2 * i] << 16), x1 = __uint_as_float(xs[2 * i] & 0xffff0000u), x2 = __uint_as_float(xs[2 * i + 1] << 16), x3 = __uint_as_float(xs[2 * i + 1] & 0xffff0000u);
        const float v0 = (y[4 * i] + ecs * yo[4 * i] + Dk * x0) * silu_r(z0), v1 = (y[4 * i + 1] + ecs * yo[4 * i + 1] + Dk * x1) * silu_r(z1);
        const float v2 = (y[4 * i + 2] + ecs * yo[4 * i + 2] + Dk * x2) * silu_r(z2), v3 = (y[4 * i + 3] + ecs * yo[4 * i + 3] + Dk * x3) * silu_r(z3);
        ssq += (v0 * v0 + v1 * v1) + (v2 * v2 + v3 * v3);
        u32x2v o; o.x = pg8::cvt_pk_bf16(v0, v1); o.y = pg8::cvt_pk_bf16(v2, v3);
        *(u32x2v*)(F.YATT() + m * DM + head * 64 + p0) = o; }
}
template <int TA, int TBB>
__device__ __forceinline__ void ssd_s3_body(Frame& F, const bf16* Bn, const bf16* Cn, const float* csw, const float* dtw, float* ssqL, bf16* WB, int m0, int head, const bf16* hs) {
    const int lane = F.lane, r = lane & 31, h = lane >> 5, w = F.wave;
    bf16x8 Wfa[TA + 1][2], Wfb[TBB + 1][2];
    { bf16x8 Cf[8]; s3_wfrags<TA>(Bn, Cn, csw, dtw, lane, Cf, Wfa); } __builtin_amdgcn_sched_barrier(0);
    { bf16x8 Cf[8]; s3_wfrags<TBB>(Bn, Cn, csw, dtw, lane, Cf, Wfb); } __builtin_amdgcn_sched_barrier(0);
    const float ecsa = __expf(csw[32 * TA + r]), ecsb = __expf(csw[32 * TBB + r]), Dk = F.in[I_DSKIP][head];
    const size_t ma = (size_t)m0 + 32 * TA + r, mb = (size_t)m0 + 32 * TBB + r;
    float ssqa = 0.f, ssqb = 0.f;
#pragma unroll 1
    for (int pb = 0; pb < 2; ++pb) {
        v4u xg[8], hg[8]; u32x2v zga[4], zgb[4];
        { const bf16* src = F.XCT() + (size_t)(head * 64 + 32 * pb) * MP + m0; const bf16* hsrc = hs + (size_t)(32 * pb) * 128;
#pragma unroll
          for (int j = 0; j < 8; ++j) { const int row = (lane >> 4) + 4 * j, ch = lane & 15; xg[j] = *(const v4u*)(src + (size_t)row * MP + 8 * ch); hg[j] = *(const v4u*)(hsrc + row * 128 + 8 * ch); }
#pragma unroll
          for (int i = 0; i < 4; ++i) { zga[i] = *(const u32x2v*)(F.PROJ() + ma * NPROJ + C_Z + head * 64 + 32 * pb + 8 * i + 4 * h); zgb[i] = *(const u32x2v*)(F.PROJ() + mb * NPROJ + C_Z + head * 64 + 32 * pb + 8 * i + 4 * h); } }
        asm volatile("s_waitcnt lgkmcnt(0)" ::: "memory"); __builtin_amdgcn_wave_barrier();
#pragma unroll
        for (int j = 0; j < 8; ++j) { const int row = (lane >> 4) + 4 * j, ch = lane & 15; *(v4u*)(WB + row * LP + 8 * ch) = xg[j]; }
        asm volatile("s_waitcnt lgkmcnt(0)" ::: "memory"); __builtin_amdgcn_wave_barrier();
        f32x16 ya, yb; unsigned xsa[8], xsb[8];
        s3_ymma<TA>(WB, Wfa, lane, ya, xsa); __builtin_amdgcn_sched_barrier(0);
        s3_ymma<TBB>(WB, Wfb, lane, yb, xsb); __builtin_amdgcn_sched_barrier(0);
        asm volatile("s_waitcnt lgkmcnt(0)" ::: "memory"); __builtin_amdgcn_wave_barrier();
#pragma unroll
        for (int j = 0; j < 8; ++j) { const int row = (lane >> 4) + 4 * j, ch = lane & 15; *(v4u*)(WB + row * LP + 8 * ch) = hg[j]; }
        asm volatile("s_waitcnt lgkmcnt(0)" ::: "memory"); __builtin_amdgcn_wave_barrier();
        s3_fin<TA>(F, WB, Cn, ya, xsa, ecsa, zga, ma, head, pb, Dk, ssqa); __builtin_amdgcn_sched_barrier(0);
        s3_fin<TBB>(F, WB, Cn, yb, xsb, ecsb, zgb, mb, head, pb, Dk, ssqb); __builtin_amdgcn_sched_barrier(0);
    }
    ssqa += __shfl_xor(ssqa, 32); ssqb += __shfl_xor(ssqb, 32);
    if (h == 0) { ssqL[w * 64 + r] = ssqa; ssqL[w * 64 + 32 + r] = ssqb; }
    __syncthreads();
    if (F.tid < 64) { float s = 0.f;
#pragma unroll
        for (int q = 0; q < 8; ++q) s += ssqL[q * 64 + F.tid];
        const int tt = (F.tid < 32) ? 32 * TA + F.tid : 32 * TBB + (F.tid - 32);
        F.RG()[((size_t)m0 + tt) * 2 + (head >> 3)] = 1.0f / sqrtf(s * (1.0f / 512.0f) + EPS); }
}
__device__ __forceinline__ void ssd_s3_item(Frame& F, int b, int c, int g, int th) {
    const int m0 = b * SEQ + c * 128, w = F.wave, head = 8 * g + w, lane = F.lane;
    bf16* Bn = (bf16*)(F.lds + RING_OFF); bf16* Cn = Bn + 128 * LP; float* csL = (float*)(F.lds + RING_OFF + 2 * 128 * LP * 2); float* dtL = csL + 8 * 128; float* ssqL = dtL + 8 * 128;
    bf16* WB = (bf16*)(F.lds + RING_OFF + 2 * 128 * LP * 2 + 10240) + (size_t)w * 32 * LP;
    __syncthreads();
#pragma unroll
    for (int i = 0; i < 8; ++i) { const int idx = F.tid + 512 * i, which = idx >> 11, rem = idx & 2047, s = rem >> 4, c16 = rem & 15;
        *(v4u*)((which ? Cn : Bn) + s * LP + c16 * 8) = *(const v4u*)(F.XC() + (size_t)(m0 + s) * CONVD + (which ? 1280 : 1024) + g * 128 + c16 * 8); }
    float* csw = csL + w * 128; float* dtw = dtL + w * 128;
    csw[lane] = F.CS()[(size_t)(m0 + lane) * 16 + head]; csw[64 + lane] = F.CS()[(size_t)(m0 + 64 + lane) * 16 + head];
    dtw[lane] = F.DT()[(size_t)(m0 + lane) * 16 + head]; dtw[64 + lane] = F.DT()[(size_t)(m0 + 64 + lane) * 16 + head];
    __syncthreads();
    const bf16* hs = F.HSb() + ((size_t)(b * 16 + head) * 16 + c) * 8192;
    if (th == 0) ssd_s3_body<0, 3>(F, Bn, Cn, csw, dtw, ssqL, WB, m0, head, hs);
    else ssd_s3_body<1, 2>(F, Bn, Cn, csw, dtw, ssqL, WB, m0, head, hs);
}
__device__ __forceinline__ void ssd_p3_phase(Frame& F) {
    for (int it = F.vcu; it < 256; it += F.G) ssd_s1_item(F, it >> 6, (it >> 2) & 15, (it >> 1) & 1, it & 1);
}
__device__ __forceinline__ void ssd_p4_phase(Frame& F, int parts = 3) {
    if (parts & 1) ssd_s2_phase(F);
    float* ssqL = (float*)(F.lds + RING_OFF);
    if (parts & 2) for (int it = blockIdx.x; it < NBS * 2; it += F.G) { const int b = it >> 1, g = it & 1;
        __syncthreads();
        ssd_sample_item(F, b, 8 * g + F.wave, ssqL);
        __syncthreads();
        if (F.tid < 4) { float s = 0.f;
#pragma unroll
            for (int q = 0; q < 8; ++q) s += ssqL[q * 4 + F.tid];
            F.RG()[((size_t)MP + 4 * b + F.tid) * 2 + g] = 1.0f / sqrtf(s * (1.0f / 512.0f) + EPS); } }
}
__device__ __forceinline__ void ssd_p5_phase(Frame& F) {
    for (int it = F.vcu; it < 256; it += F.G) ssd_s3_item(F, it >> 6, (it >> 2) & 15, (it >> 1) & 1, it & 1);
}
constexpr float LOG2E = 1.4426950408889634f;
template <int NKB, int NKS, int NDB, bool MIDFULL = false, class MaskF>
__device__ __forceinline__ void attn_chunk(const bf16* Kt, int KP, const bf16* VT, int VP, int key0, const bf16x8 (&q)[NKS], float scale2, MaskF mask, float& mx, float& l, f32x16 (&o)[NDB], int lane) {
    const int r = lane & 31, h = lane >> 5;
    f32x16 S[NKB];
#pragma unroll
    for (int kb = 0; kb < NKB; ++kb) {
#pragma unroll
        for (int i = 0; i < 16; ++i) S[kb][i] = 0.f;
#pragma unroll
        for (int ks = 0; ks < NKS; ++ks) { const bf16x8 A = *(const bf16x8*)(Kt + (key0 + 32 * kb + r) * KP + 16 * ks + 8 * h); S[kb] = MFMA32(A, q[ks], S[kb]); }
        __builtin_amdgcn_sched_barrier(0);
    }
    float cmax = -INFINITY;
#pragma unroll
    for (int kb = 0; kb < NKB; ++kb)
#pragma unroll
        for (int i = 0; i < 16; ++i) { const int key = key0 + 32 * kb + (i & 3) + 8 * (i >> 2) + 4 * h; const bool ok = (MIDFULL && kb > 0 && kb < NKB - 1) ? true : mask(key);
            const float v = ok ? S[kb][i] : -INFINITY; S[kb][i] = v; cmax = fmaxf(cmax, v); }
    cmax = fmaxf(cmax, __shfl_xor(cmax, 32)) * scale2;
    const float mn = fmaxf(mx, cmax), al = __builtin_amdgcn_exp2f(mx - mn); mx = mn; l *= al;
#pragma unroll
    for (int db = 0; db < NDB; ++db)
#pragma unroll
        for (int i = 0; i < 16; ++i) o[db][i] *= al;
    float ps = 0.f;
#pragma unroll
    for (int kb = 0; kb < NKB; ++kb)
#pragma unroll
        for (int i = 0; i < 16; ++i) { const float p = __builtin_amdgcn_exp2f(__builtin_fmaf(S[kb][i], scale2, -mn)); S[kb][i] = p; ps += p; }
    ps += __shfl_xor(ps, 32); l += ps;
#pragma unroll
    for (int kb = 0; kb < NKB; ++kb)
#pragma unroll
        for (int s2 = 0; s2 < 2; ++s2) {
            u32x4 pw; pw.x = pg8::cvt_pk_bf16(S[kb][8 * s2], S[kb][8 * s2 + 1]); pw.y = pg8::cvt_pk_bf16(S[kb][8 * s2 + 2], S[kb][8 * s2 + 3]);
            pw.z = pg8::cvt_pk_bf16(S[kb][8 * s2 + 4], S[kb][8 * s2 + 5]); pw.w = pg8::cvt_pk_bf16(S[kb][8 * s2 + 6], S[kb][8 * s2 + 7]);
            const bf16x8 Pf = __builtin_bit_cast(bf16x8, pw);
#pragma unroll
            for (int db = 0; db < NDB; ++db) { const bf16* vp = VT + (32 * db + r) * VP + key0 + 32 * kb + 16 * s2 + 4 * h;
                const u32x2v lo = *(const u32x2v*)vp, hi = *(const u32x2v*)(vp + 8); u32x4 av; av.x = lo.x; av.y = lo.y; av.z = hi.x; av.w = hi.y;
                o[db] = MFMA32(__builtin_bit_cast(bf16x8, av), Pf, o[db]); }
            __builtin_amdgcn_sched_barrier(0);
        }
}
template <int NDB>
__device__ __forceinline__ void attn_store(const f32x16 (&o)[NDB], float l, bf16* orow, int lane) {
    const int h = lane >> 5; const float il = 1.0f / l;
#pragma unroll
    for (int db = 0; db < NDB; ++db)
#pragma unroll
        for (int i = 0; i < 4; ++i) { u32x2v w; w.x = pg8::cvt_pk_bf16(o[db][4 * i] * il, o[db][4 * i + 1] * il); w.y = pg8::cvt_pk_bf16(o[db][4 * i + 2] * il, o[db][4 * i + 3] * il);
            *(u32x2v*)(orow + 32 * db + 8 * i + 4 * h) = w; }
}
__device__ __forceinline__ void attn_store64_lds(const f32x16 (&o)[2], float l, bf16* T, bf16* obase, size_t rstride, int lane) {
    const int r = lane & 31, h = lane >> 5; const float il = 1.0f / l;
#pragma unroll
    for (int db = 0; db < 2; ++db)
#pragma unroll
        for (int i = 0; i < 4; ++i) { u32x2v w; w.x = pg8::cvt_pk_bf16(o[db][4 * i] * il, o[db][4 * i + 1] * il); w.y = pg8::cvt_pk_bf16(o[db][4 * i + 2] * il, o[db][4 * i + 3] * il);
            *(u32x2v*)(T + r * 72 + 32 * db + 8 * i + 4 * h) = w; }
    asm volatile("s_waitcnt lgkmcnt(0)" ::: "memory"); __builtin_amdgcn_wave_barrier();
#pragma unroll
    for (int j = 0; j < 4; ++j) { const int row = 8 * j + (lane >> 3), ch = lane & 7; *(v4u*)(obase + (size_t)row * rstride + 8 * ch) = *(const v4u*)(T + row * 72 + 8 * ch); }
    asm volatile("s_waitcnt lgkmcnt(0)" ::: "memory"); __builtin_amdgcn_wave_barrier();
}
__device__ __forceinline__ void load_q64_rope(const bf16* qrow, const float* cs, bf16x8 (&q)[4], int lane) {
    const int h = lane >> 5;
#pragma unroll
    for (int ks = 0; ks < 4; ++ks) q[ks] = *(const bf16x8*)(qrow + 16 * ks + 8 * h);
    float my[8], ot[8]; unpack8(__builtin_bit_cast(v4u, q[0]), my);
#pragma unroll
    for (int i = 0; i < 8; ++i) ot[i] = __shfl_xor(my[i], 32);
#pragma unroll
    for (int i = 0; i < 8; ++i) { const float c = cs[2 * i], s = cs[2 * i + 1]; my[i] = h ? (my[i] * c + ot[i] * s) : (my[i] * c - ot[i] * s); }
    q[0] = __builtin_bit_cast(bf16x8, pack8c(my));
}
__device__ __forceinline__ void stage_k_chunk(bf16* Kt, int KP, int row, int c, const bf16* krow, const float* cs) {
    if (c == 1 && cs) return;
    if (!krow) { const v4u z = {0u, 0u, 0u, 0u}; *(v4u*)(Kt + row * KP + c * 8) = z; if (c == 0 && cs) *(v4u*)(Kt + row * KP + 8) = z; return; }
    if (c == 0 && cs) { float x1[8], x2[8]; unpack8(*(const v4u*)krow, x1); unpack8(*(const v4u*)(krow + 8), x2); float a[8], b[8];
#pragma unroll
        for (int i = 0; i < 8; ++i) { const float co = cs[2 * i], si = cs[2 * i + 1]; a[i] = x1[i] * co - x2[i] * si; b[i] = x2[i] * co + x1[i] * si; }
        *(v4u*)(Kt + row * KP) = pack8c(a); *(v4u*)(Kt + row * KP + 8) = pack8c(b); return; }
    *(v4u*)(Kt + row * KP + c * 8) = *(const v4u*)(krow + c * 8);
}
__device__ __forceinline__ void stage_vt_chunk(bf16* VT, int VP, int row, int c, v4u v) {
    bf16* p = VT + (c * 8) * VP + row;
    p[0] = (bf16)(v.x & 0xffffu); p[VP] = (bf16)(v.x >> 16); p[2 * VP] = (bf16)(v.y & 0xffffu); p[3 * VP] = (bf16)(v.y >> 16);
    p[4 * VP] = (bf16)(v.z & 0xffffu); p[5 * VP] = (bf16)(v.z >> 16); p[6 * VP] = (bf16)(v.w & 0xffffu); p[7 * VP] = (bf16)(v.w >> 16);
}
__device__ __forceinline__ v4u ld8_f32_as_bf16(const float* p) { const f32x4 a = *(const f32x4*)p, b = *(const f32x4*)(p + 4); v4u w; w.x = pg8::cvt_pk_bf16(a.x, a.y); w.y = pg8::cvt_pk_bf16(a.z, a.w); w.z = pg8::cvt_pk_bf16(b.x, b.y); w.w = pg8::cvt_pk_bf16(b.z, b.w); return w; }

constexpr int SKP = 72, SVP = 196;
__device__ __forceinline__ void p2_phase(Frame& F, int parts = 6) {
    const int nthr = F.G * 512, gt = blockIdx.x * 512 + F.tid;
    for (int idx = gt; idx < NBP * 3 * CONVD; idx += nthr) { const int b = idx / (3 * CONVD), i = (idx / CONVD) % 3, ch = idx % CONVD;
        F.out[O_PCONV + idx] = bf2f(F.PROJ()[(size_t)(b * SEQ + SEQ - 3 + i) * NPROJ + C_X + ch]); }
    for (int idx = gt; idx < NBS * 3 * CONVD; idx += nthr) { const int b = idx / (3 * CONVD), i = (idx / CONVD) % 3, ch = idx % CONVD;
        F.out[O_SCONV + idx] = bf2f(F.PROJ()[(size_t)(MP + 4 * b + 1 + i) * NPROJ + C_X + ch]); }
    bf16* Kt = (bf16*)(F.lds + RING_OFF); bf16* VT = Kt + 192 * SKP;
    const int lane = F.lane, r = lane & 31;
    for (int it = F.vcu; it < 512; it += F.G) {
        if (!(parts & (it < 256 ? 2 : 4))) continue;
        __syncthreads();
        if (it < 256) {
            const int b = it >> 6, tile = (it >> 1) & 31, g = it & 1, t0 = tile * 64;
            { v4u kq[3], k2[3], vq[3];
#pragma unroll
              for (int i = 0; i < 3; ++i) { const int ci = F.tid + 512 * i, row = ci >> 3, c = ci & 7, s = t0 - 128 + row; const bool ok = (s >= 0 && s < SEQ);
                  const bf16* pr = F.PROJ() + (size_t)(b * SEQ + (ok ? s : 0)) * NPROJ;
                  kq[i] = *(const v4u*)(pr + C_K + g * 64 + c * 8); vq[i] = *(const v4u*)(pr + C_V + g * 64 + c * 8); k2[i] = kq[i]; if (c == 0) k2[i] = *(const v4u*)(pr + C_K + g * 64 + 8); }
#pragma unroll
              for (int i = 0; i < 3; ++i) { const int ci = F.tid + 512 * i, row = ci >> 3, c = ci & 7, s = t0 - 128 + row; const bool ok = (s >= 0 && s < SEQ);
                  const v4u z4 = {0u, 0u, 0u, 0u};
                  stage_vt_chunk(VT, SVP, row, c, ok ? vq[i] : z4);
                  if (c == 0) { float x1[8], x2[8], a[8], bb[8]; unpack8(kq[i], x1); unpack8(k2[i], x2); const float* cs = F.ROPE() + (size_t)(ok ? s : 0) * 16;
#pragma unroll
                      for (int e = 0; e < 8; ++e) { const float co = cs[2 * e], si = cs[2 * e + 1]; a[e] = x1[e] * co - x2[e] * si; bb[e] = x2[e] * co + x1[e] * si; }
                      *(v4u*)(Kt + row * SKP) = ok ? pack8c(a) : z4; *(v4u*)(Kt + row * SKP + 8) = ok ? pack8c(bb) : z4; }
                  else if (c >= 2) *(v4u*)(Kt + row * SKP + c * 8) = ok ? kq[i] : z4; } }
            __syncthreads();
            if (tile == 31) {
                for (int e = F.tid; e < 128 * 64; e += 512) { const int j = e >> 6, d = e & 63; const size_t o = ((size_t)(b * 128 + j) * 2 + g) * 64 + d;
                    F.out[O_PSK + o] = bf2f(Kt[(64 + j) * SKP + d]); F.out[O_PSV + o] = bf2f(VT[d * SVP + 64 + j]); } }
            const int head = g * 8 + F.wave; const float sink2 = F.in[I_SINKS][head] * LOG2E;
#pragma unroll 1
            for (int qb = 0; qb < 2; ++qb) {
                const int t = t0 + 32 * qb + r; const size_t m = (size_t)b * SEQ + t;
                bf16x8 q[4]; load_q64_rope(F.PROJ() + m * NPROJ + C_Q + head * 64, F.ROPE() + (size_t)t * 16, q, lane);
                float mx = sink2, l = 1.0f; f32x16 o[2];
#pragma unroll
                for (int db = 0; db < 2; ++db)
#pragma unroll
                    for (int i = 0; i < 16; ++i) o[db][i] = 0.f;
                const int relb = 32 * qb + r + 128;
                if (t0 >= 128) attn_chunk<5, 4, 2, true>(Kt, SKP, VT, SVP, 32 * qb, q, 0.125f * LOG2E, [=](int key) { const int rel = relb - key; return rel >= 0 && rel < 128; }, mx, l, o, lane);
                else attn_chunk<5, 4, 2>(Kt, SKP, VT, SVP, 32 * qb, q, 0.125f * LOG2E, [=](int key) { const int rel = relb - key; return rel >= 0 && rel < 128 && (t0 - 128 + key) >= 0; }, mx, l, o, lane);
                attn_store64_lds(o, l, (bf16*)(F.lds + RING_OFF + 65536) + F.wave * (32 * 72), F.YATT() + ((size_t)b * SEQ + t0 + 32 * qb) * DM + 1024 + head * 64, (size_t)DM, lane);
            }
        } else {
            const int b = (it - 256) >> 1, g = it & 1;
            { f32x4 kc[4], vc[4];
#pragma unroll
              for (int i = 0; i < 4; ++i) { const int ci = F.tid + 512 * i, row = ci >> 4, c16 = ci & 15; const size_t o = ((size_t)(b * 128 + row) * 2 + g) * 64 + c16 * 4;
                  kc[i] = ldnt((const f32x4*)(F.in[I_CSK] + o)); vc[i] = ldnt((const f32x4*)(F.in[I_CSV] + o)); }
#pragma unroll
              for (int i = 0; i < 4; ++i) { const int ci = F.tid + 512 * i, row = ci >> 4, c16 = ci & 15;
                  if (row >= 4) { const size_t o = ((size_t)(b * 128 + row - 4) * 2 + g) * 64 + c16 * 4; stnt((f32x4*)(F.out + O_SSK + o), kc[i]); stnt((f32x4*)(F.out + O_SSV + o), vc[i]); }
                  u32x2v kw; kw.x = pg8::cvt_pk_bf16(kc[i].x, kc[i].y); kw.y = pg8::cvt_pk_bf16(kc[i].z, kc[i].w); *(u32x2v*)(Kt + row * SKP + c16 * 4) = kw;
                  bf16* vp = VT + (c16 * 4) * SVP + row; const unsigned v01 = pg8::cvt_pk_bf16(vc[i].x, vc[i].y), v23 = pg8::cvt_pk_bf16(vc[i].z, vc[i].w);
                  vp[0] = (bf16)(v01 & 0xffffu); vp[SVP] = (bf16)(v01 >> 16); vp[2 * SVP] = (bf16)(v23 & 0xffffu); vp[3 * SVP] = (bf16)(v23 >> 16); } }
            for (int ci = F.tid; ci < 32 * 8; ci += 512) { const int row = 128 + (ci >> 3), c = ci & 7;
                if (row < 132) { const int tt = row - 128; const bf16* pr = F.PROJ() + (size_t)(MP + 4 * b + tt) * NPROJ;
                    stage_k_chunk(Kt, SKP, row, c, pr + C_K + g * 64, F.ROPE() + (size_t)(2048 + tt) * 16); stage_vt_chunk(VT, SVP, row, c, *(const v4u*)(pr + C_V + g * 64 + c * 8));
                } else { const v4u z = {0u, 0u, 0u, 0u}; *(v4u*)(Kt + row * SKP + c * 8) = z; stage_vt_chunk(VT, SVP, row, c, z); } }
            __syncthreads();
            if (F.tid < 64) { const int j = 124 + (F.tid >> 4), d = (F.tid & 15) * 4; const size_t o = ((size_t)(b * 128 + j) * 2 + g) * 64 + d;
                const bf16* kr = Kt + (4 + j) * SKP + d; const f32x4 kk = {bf2f(kr[0]), bf2f(kr[1]), bf2f(kr[2]), bf2f(kr[3])};
                const f32x4 vv = {bf2f(VT[d * SVP + 4 + j]), bf2f(VT[(d + 1) * SVP + 4 + j]), bf2f(VT[(d + 2) * SVP + 4 + j]), bf2f(VT[(d + 3) * SVP + 4 + j])};
                stnt((f32x4*)(F.out + O_SSK + o), kk); stnt((f32x4*)(F.out + O_SSV + o), vv); }
            if (F.wave == 0) {
                const int head = g * 8 + (r >> 2), tok = r & 3; const size_t m = (size_t)MP + 4 * b + tok;
                bf16x8 q[4]; load_q64_rope(F.PROJ() + m * NPROJ + C_Q + head * 64, F.ROPE() + (size_t)(2048 + tok) * 16, q, lane);
                float mx = F.in[I_SINKS][head] * LOG2E, l = 1.0f; f32x16 o[2];
#pragma unroll
                for (int db = 0; db < 2; ++db)
#pragma unroll
                    for (int i = 0; i < 16; ++i) o[db][i] = 0.f;
                attn_chunk<5, 4, 2>(Kt, SKP, VT, SVP, 0, q, 0.125f * LOG2E, [=](int key) { return key > tok && key <= tok + 128; }, mx, l, o, lane);
                attn_store<2>(o, l, F.YATT() + m * DM + 1024 + head * 64, lane);
            }
        }
    }
}

constexpr int XKP = 136, XVP = 260;
__device__ __forceinline__ void p7_phase(Frame& F) {
    const int lane = F.lane, r = lane & 31;
    const bool split = (F.G == 256); const int hv = F.vcu >> 1; const bool odd = F.vcu & 1;
    const int pit0 = split ? (odd ? 256 : 2 * hv) : F.vcu, pit1 = split ? (odd ? 0 : 2 * hv + 2) : 256, pstep = split ? 1 : F.G;
    const int sit0 = split ? (odd ? 128 + 3 * hv : hv) : (int)blockIdx.x, scnt = split ? (odd ? 3 : 1) : (512 - (int)blockIdx.x + F.G - 1) / F.G, sstep = split ? 1 : F.G;
#ifndef XA_NO_PROMPT
    { bf16* Kt = (bf16*)(F.lds + RING_OFF); bf16* VT = Kt + 256 * XKP;
      for (int it = pit0; it < pit1; it += pstep) {
        const int b = it >> 6, hh = (it >> 4) & 3, tile = it & 15; const size_t m0 = (size_t)b * SEQ + tile * 128;
        __syncthreads();
        { v4u kq[8], vq[8];
#pragma unroll
          for (int i = 0; i < 8; ++i) { const int ci = F.tid + 512 * i, row = ci >> 4, c = ci & 15; const bf16* src = F.MKV() + (size_t)(b * NMEM + row) * 1024 + hh * 128 + c * 8; kq[i] = *(const v4u*)src; vq[i] = *(const v4u*)(src + 512); }
#pragma unroll
          for (int i = 0; i < 8; ++i) { const int ci = F.tid + 512 * i, row = ci >> 4, c = ci & 15; *(v4u*)(Kt + row * XKP + c * 8) = kq[i]; stage_vt_chunk(VT, XVP, row, c, vq[i]); } }
        __syncthreads();
        if (F.wave < 4) { const size_t m = m0 + 32 * F.wave + r;
            bf16x8 q[8];
#pragma unroll
            for (int ks = 0; ks < 8; ++ks) q[ks] = *(const bf16x8*)(F.QX() + m * XW + hh * 128 + 16 * ks + 8 * (lane >> 5));
            float mx = -INFINITY, l = 0.f; f32x16 o[4];
#pragma unroll
            for (int db = 0; db < 4; ++db)
#pragma unroll
                for (int i = 0; i < 16; ++i) o[db][i] = 0.f;
#pragma unroll 1
            for (int kc = 0; kc < 256; kc += 64) attn_chunk<2, 8, 4>(Kt, XKP, VT, XVP, kc, q, 0.08838834764831845f * LOG2E, [](int) { return true; }, mx, l, o, lane);
            { bf16* T = (bf16*)(F.lds + RING_OFF + 136192) + F.wave * (32 * 72); bf16* ob = F.OX() + (m0 + 32 * F.wave) * XW + hh * 128;
              const f32x16 oa[2] = {o[0], o[1]}, oc[2] = {o[2], o[3]};
              attn_store64_lds(oa, l, T, ob, (size_t)XW, lane); attn_store64_lds(oc, l, T, ob + 64, (size_t)XW, lane); } }
      } }
#endif
#ifndef XA_NO_SAMPLE
    { float* qs = (float*)(F.lds + RING_OFF); float* S = qs + 4 * 128; float* red = S + 4 * 256;
      const int d4 = F.tid & 31, kg = F.tid >> 5, kh = (F.lane >> 5) & 1;
      f32x4 kq[16], vq[16];
#define XA_LOADK(it_) do { const float* kr_ = F.in[I_CMK] + ((size_t)(((it_) >> 2) * NMEM + 32 * F.wave + kh) * 4 + ((it_) & 3)) * 128 + 4 * d4; _Pragma("unroll") for (int i = 0; i < 16; ++i) kq[i] = ldnt((const f32x4*)(kr_ + (size_t)(2 * i) * 512)); } while (0)
#define XA_LOADV(it_) do { _Pragma("unroll") for (int kk = 0; kk < 16; ++kk) vq[kk] = ldnt((const f32x4*)(F.in[I_CMV] + ((size_t)(((it_) >> 2) * NMEM + kg * 16 + kk) * 4 + ((it_) & 3)) * 128 + 4 * d4)); } while (0)
#define XA_LOADQ(it_) bf2f(F.QX()[((size_t)MP + 4 * ((it_) >> 2) + (F.tid >> 7)) * XW + ((it_) & 3) * 128 + (F.tid & 127)])
      int it = sit0; float qn = 0.f;
      if (scnt > 0) { qn = XA_LOADQ(it); XA_LOADK(it); XA_LOADV(it); }
      for (int left = scnt; left > 0; --left, it += sstep) {
        const int b = it >> 2, hh = it & 3; const size_t m0 = (size_t)MP + 4 * b; const bool more = left > 1;
        __syncthreads();
        { const int t = F.tid >> 7, d = F.tid & 127; qs[t * 128 + d] = qn * 0.08838834764831845f; }
        __syncthreads();
        { const f32x4 q0 = *(const f32x4*)(qs + 4 * d4), q1 = *(const f32x4*)(qs + 128 + 4 * d4), q2 = *(const f32x4*)(qs + 256 + 4 * d4), q3 = *(const f32x4*)(qs + 384 + 4 * d4);
          const bool b4 = (F.lane >> 4) & 1, b3 = (F.lane >> 3) & 1;
#pragma unroll
          for (int i = 0; i < 16; ++i) { const f32x4 k4 = kq[i];
              float a0 = (k4.x * q0.x + k4.y * q0.y) + (k4.z * q0.z + k4.w * q0.w), a1 = (k4.x * q1.x + k4.y * q1.y) + (k4.z * q1.z + k4.w * q1.w);
              float a2 = (k4.x * q2.x + k4.y * q2.y) + (k4.z * q2.z + k4.w * q2.w), a3 = (k4.x * q3.x + k4.y * q3.y) + (k4.z * q3.z + k4.w * q3.w);
              { const float s0 = b4 ? a0 : a2, s1 = b4 ? a1 : a3, k0 = b4 ? a2 : a0, k1 = b4 ? a3 : a1; a0 = k0 + __shfl_xor(s0, 16); a1 = k1 + __shfl_xor(s1, 16); }
              { const float s0 = b3 ? a0 : a1, k0 = b3 ? a1 : a0; a0 = k0 + __shfl_xor(s0, 8); }
              a0 += __shfl_xor(a0, 4); a0 += __shfl_xor(a0, 2); a0 += __shfl_xor(a0, 1);
              if ((F.lane & 7) == 0) S[(2 * (int)b4 + (int)b3) * 256 + 32 * F.wave + 2 * i + kh] = a0; } }
        if (more) { qn = XA_LOADQ(it + sstep); XA_LOADK(it + sstep); }
        __syncthreads();
        if (F.wave < 4) { float v[4]; float mx = -INFINITY;
#pragma unroll
            for (int i = 0; i < 4; ++i) { v[i] = S[F.wave * 256 + lane + 64 * i]; mx = fmaxf(mx, v[i]); }
#pragma unroll
            for (int o = 1; o < 64; o <<= 1) mx = fmaxf(mx, __shfl_xor(mx, o));
            float s = 0.f;
#pragma unroll
            for (int i = 0; i < 4; ++i) { v[i] = __expf(v[i] - mx); s += v[i]; }
            s = 1.0f / wave_sum(s);
#pragma unroll
            for (int i = 0; i < 4; ++i) S[F.wave * 256 + lane + 64 * i] = v[i] * s; }
        __syncthreads();
        { f32x4 acc[4];
#pragma unroll
          for (int t = 0; t < 4; ++t) acc[t] = (f32x4){0.f, 0.f, 0.f, 0.f};
#pragma unroll
          for (int kk = 0; kk < 16; ++kk) { const int ky = kg * 16 + kk;
#pragma unroll
              for (int t = 0; t < 4; ++t) acc[t] = acc[t] + vq[kk] * S[t * 256 + ky]; }
#pragma unroll
          for (int t = 0; t < 4; ++t) *(f32x4*)(red + (kg * 4 + t) * 128 + 4 * d4) = acc[t]; }
        if (more) XA_LOADV(it + sstep);
        __syncthreads();
        { const int t = F.tid >> 7, d = F.tid & 127; float s = 0.f;
#pragma unroll
          for (int q = 0; q < 16; ++q) s += red[(q * 4 + t) * 128 + d];
          F.OX()[(m0 + t) * XW + hh * 128 + d] = (bf16)f2bf(s); }
      }
#undef XA_LOADK
#undef XA_LOADQ
#undef XA_LOADV
    }
#endif
}
__device__ __forceinline__ void p11_phase(Frame& F) {
    const int gw = blockIdx.x * NWAVES + F.wave, NGW = F.G * NWAVES;
    f32x4 g[8];
#pragma unroll
    for (int j = 0; j < 8; ++j) g[j] = ((const f32x4*)F.in[I_NFINAL])[F.lane + 64 * j];
    u32x2v cur[8], nxt[8];
    if (gw < M) { const u32x2v* xr = (const u32x2v*)(F.XB() + (size_t)gw * DM) + F.lane;
#pragma unroll
        for (int j = 0; j < 8; ++j) cur[j] = xr[64 * j]; }
#pragma unroll 1
    for (int m = gw; m < M; m += NGW) {
        { const int ml = (m + NGW < M) ? m + NGW : m; const u32x2v* xr = (const u32x2v*)(F.XB() + (size_t)ml * DM) + F.lane;
#pragma unroll
          for (int j = 0; j < 8; ++j) nxt[j] = xr[64 * j]; }
        f32x4 v[8]; float s = 0.f;
#pragma unroll
        for (int j = 0; j < 8; ++j) { const u32x2v q = cur[j]; v[j] = (f32x4){__uint_as_float(q.x << 16), __uint_as_float(q.x & 0xffff0000u), __uint_as_float(q.y << 16), __uint_as_float(q.y & 0xffff0000u)}; }
        if (F.G == 256 && m >= MP) {
            const f32x4* sl = (const f32x4*)((const float*)(F.ws + WS_SLAB) + (size_t)(m - MP) * DM) + F.lane;
#pragma unroll 2
            for (int q = 0; q < 8; ++q)
#pragma unroll
                for (int j = 0; j < 8; ++j) v[j] = v[j] + sl[(size_t)q * (512 * DM / 4) + 64 * j]; }
#pragma unroll
        for (int j = 0; j < 8; ++j) s += (v[j].x * v[j].x + v[j].y * v[j].y) + (v[j].z * v[j].z + v[j].w * v[j].w);
        const float rstd = 1.0f / sqrtf(wave_sum(s) * (1.0f / DM) + EPS);
        f32x4* orow = (f32x4*)(F.out + (size_t)m * DM) + F.lane;
#pragma unroll
        for (int j = 0; j < 8; ++j) stnt(orow + 64 * j, v[j] * rstd * g[j]);
#pragma unroll
        for (int j = 0; j < 8; ++j) cur[j] = nxt[j];
    }
}
struct Args { const float* in[30]; float* out; unsigned char* ws; int ph_lo, ph_hi, li, pad; };
__global__ void __launch_bounds__(NWAVES * 64, 2) hymba_fwd(Args args) {
    extern __shared__ __attribute__((aligned(16))) unsigned char lds[];
    Frame F;
    F.lds = lds; F.ldsl = (LAS unsigned char*)lds;
    F.MISC = (volatile LAS unsigned*)(F.ldsl + MISC_OFF);
    F.tid = threadIdx.x; F.lane = F.tid & 63; F.wave = __builtin_amdgcn_readfirstlane(F.tid >> 6); F.G = gridDim.x; { const int bx = blockIdx.x; F.vcu = (F.G % 8 == 0) ? (bx % 8) * (F.G / 8) + bx / 8 : bx; }
    unsigned char* ws = args.ws; F.ws = ws; F.out = args.out;
#pragma unroll
    for (int i = 0; i < 30; ++i) F.in[i] = args.in[i];
    F.ctl = (gu32*)(ws + WS_CTL);
    for (int u = F.tid; u < (LDS_BYTES - LDSCTL_OFF) / 4; u += NWAVES * 64) ((LAS unsigned*)(F.ldsl + LDSCTL_OFF))[u] = 0u;
    __syncthreads();
    XcdBarrier bar; bar.bar = (unsigned*)(F.ctl + CW_BAR) + args.li * XCD_BAR_WORDS; bar.x = 0; bar.st = nullptr;
    if (MK_ONE_LAUNCH) bar = xcd_barrier_post((unsigned*)(F.ctl + CW_BAR) + args.li * XCD_BAR_WORDS, F.MISC + 8);
#define GRID_BAR() do { if (MK_ONE_LAUNCH) xcd_barrier(bar); } while (0)
    const int lo = args.ph_lo, hi = args.ph_hi;
#ifndef P0PARTS
#define P0PARTS 7
#endif
#ifndef P4PARTS
#define P4PARTS 3
#endif
#ifndef P2PARTS
#define P2PARTS 7
#endif
#ifndef DUPMASK
#define DUPMASK 0
#endif
#ifndef PHMASK
#define PHMASK 0x1FFF
#endif
#define IN(k) (((PHMASK >> (k)) & 1) && lo <= (k) && (k) < hi)
#define BOTH(k) (IN(k) && IN((k) + 1))
    float* const xres = F.out + O_Y;

#define DUP(k) ((DUPMASK >> (k)) & 1)
    if (IN(0)) { p0_prologue(F, args.li == 1 ? P0PARTS : 7); if (BOTH(0)) GRID_BAR(); if (DUP(0)) { p0_prologue(F); GRID_BAR(); } }
    if (IN(1)) {
        pg8::Gemm g{F.XB(), F.Wt_in(), M, NPROJ, DM}; pg8::StaticOrder S; S.init(M, NPROJ, F.G, (int)blockIdx.x);
        pg8::EpiBf16S E{F.PROJ(), NPROJ, nullptr};
        pg8::gemm_phase<pg8::EpiBf16S, pg8::StaticOrder, PG8_ALIGN, PG8_SP2>(F.ldsl + RING_OFF, g, S, E);
        if (BOTH(1)) GRID_BAR();
        if (DUP(1)) { pg8::gemm_phase<pg8::EpiBf16S, pg8::StaticOrder, PG8_ALIGN, PG8_SP2>(F.ldsl + RING_OFF, g, S, E); GRID_BAR(); }
    }
    if (IN(2)) { if (args.li != 1 || (P2PARTS & 1)) conv_phase(F); if (args.li != 1 || (P2PARTS & 6)) p2_phase(F, args.li == 1 ? P2PARTS : 6); if (BOTH(2)) GRID_BAR(); if ((DUPMASK >> 2) & 1) { if (P2PARTS & 1) conv_phase(F); if (P2PARTS & 2) p2_phase(F); GRID_BAR(); } }
    if (IN(3)) { ssd_p3_phase(F); if (BOTH(3)) GRID_BAR(); if (DUP(20)) { for (int q = 0; q < 8; ++q) GRID_BAR(); } if (DUP(3)) { ssd_p3_phase(F); GRID_BAR(); } }
    if (IN(4)) { ssd_p4_phase(F, args.li == 1 ? P4PARTS : 3); if (BOTH(4)) GRID_BAR(); if (DUP(4)) { ssd_p4_phase(F); GRID_BAR(); } }
    if (IN(5)) {
#pragma unroll 1
        for (int rep = 0; rep < 1 + DUP(5); ++rep) { ssd_p5_phase(F); if (BOTH(5)) GRID_BAR(); } }
    if (IN(6)) {
        pg8::Gemm g{F.YATT(), F.Wt_out(), M, DM, DM};
        if (F.G == 256) {
            pg8::TailOrder S; S.init(MP, DM, F.G, (int)blockIdx.x); S.mode = 1;
            pg8::EpiResidB<true, true> E{F.in[I_XP], F.in[I_XS], F.XB(), F.SSQ1(), F.RG(), (float*)(ws + WS_ST), F.XB()};
            pg8::gemm_phase<pg8::EpiResidB<true, true>, pg8::TailOrder, PG8_ALIGN, PG8_SP2>(F.ldsl + RING_OFF, g, S, E);
            xattn_weight_copies(F, 128, F.G);
            GRID_BAR();
            for (int it = blockIdx.x * NWAVES + F.wave; it < MS * 4; it += F.G * NWAVES) { const int r = it >> 2, j = it & 3;
                const float* xr = F.in[I_XS] + (size_t)r * DM + 512 * j + 8 * F.lane; const float* sl = (const float*)(ws + WS_ST) + (size_t)r * DM + 512 * j + 8 * F.lane;
                f32x4 a = *(const f32x4*)xr, b = *(const f32x4*)(xr + 4), sa[8], sb[8];
#pragma unroll
                for (int q = 0; q < 8; ++q) { sa[q] = *(const f32x4*)(sl + (size_t)q * 512 * DM); sb[q] = *(const f32x4*)(sl + (size_t)q * 512 * DM + 4); }
#pragma unroll
                for (int q = 0; q < 8; ++q) { a = a + sa[q]; b = b + sb[q]; }
                const float v[8] = {a.x, a.y, a.z, a.w, b.x, b.y, b.z, b.w}; float s = 0.f;
#pragma unroll
                for (int i = 0; i < 8; ++i) s += v[i] * v[i];
                *(v4u*)(F.XB() + (size_t)(MP + r) * DM + 512 * j + 8 * F.lane) = pack8c(v);
                s = wave_sum(s); if (F.lane == 0) atomicAdd(F.SSQ1() + MP + r, s);
            }
        } else {
            pg8::StaticOrder S; S.init(M, DM, F.G, (int)blockIdx.x);
            pg8::EpiResidB<true, true> E{F.in[I_XP], F.in[I_XS], F.XB(), F.SSQ1(), F.RG(), nullptr, F.XB()};
            pg8::gemm_phase<pg8::EpiResidB<true, true>, pg8::StaticOrder, PG8_ALIGN, PG8_SP2>(F.ldsl + RING_OFF, g, S, E);
            xattn_weight_copies(F, 0, F.G);
        }
        if (BOTH(6)) GRID_BAR();
    }
    if (IN(7)) {
        { pg8::Gemm g{F.XB(), F.Wt_xq(), M, XW, DM}; pg8::StaticOrder S; S.init(M, XW, F.G, (int)blockIdx.x);
          pg8::EpiBf16S E{F.QX(), XW, F.SSQ1()};
          pg8::gemm_phase<pg8::EpiBf16S, pg8::StaticOrder, PG8_ALIGN, PG8_SP2>(F.ldsl + RING_OFF, g, S, E); }
        { pg8::Gemm g{F.MN(), F.Wt_kv(), MM, 1024, DM}; pg8::StaticOrder S; S.init(MM, 1024, F.G, (int)(F.G - 1 - blockIdx.x));
          pg8::EpiMemKV E{F.out + O_PMK, F.out + O_PMV, F.MKV()};
          pg8::gemm_phase<pg8::EpiMemKV, pg8::StaticOrder, PG8_ALIGN, PG8_SP2>(F.ldsl + RING_OFF, g, S, E); }
        ffn_weight_copies(F, 0, 68, F.G - 16);
        if (BOTH(7)) GRID_BAR();
        if (DUP(7)) { { pg8::Gemm g{F.XB(), F.Wt_xq(), M, XW, DM}; pg8::StaticOrder S; S.init(M, XW, F.G, (int)blockIdx.x); pg8::EpiBf16S E{F.QX(), XW, F.SSQ1()};
                        pg8::gemm_phase<pg8::EpiBf16S, pg8::StaticOrder, PG8_ALIGN, PG8_SP2>(F.ldsl + RING_OFF, g, S, E); } GRID_BAR(); }
    }
    if (IN(8)) {
#pragma unroll 1
        for (int rep = 0; rep < 1 + DUP(8); ++rep) { p7_phase(F); if (BOTH(8)) GRID_BAR(); } }
    if (IN(9)) {
        pg8::Gemm g{F.OX(), F.Wt_xo(), M, DM, XW}; pg8::StaticOrder S; S.init(M, DM, F.G, (int)blockIdx.x);
        pg8::EpiResidB<false, false> E{nullptr, nullptr, F.XB(), F.SSQ2(), nullptr, nullptr, F.XB()};
        pg8::gemm_phase<pg8::EpiResidB<false, false>, pg8::StaticOrder, PG8_ALIGN, PG8_SP2>(F.ldsl + RING_OFF, g, S, E);
        ffn_weight_copies(F, 1, 16, F.G);
        if (BOTH(9)) GRID_BAR();
        if (DUP(9)) { pg8::EpiResidB<false, false> E2{nullptr, nullptr, F.XB(), nullptr, nullptr, nullptr, (bf16*)(ws + WS_ST)}; pg8::gemm_phase<pg8::EpiResidB<false, false>, pg8::StaticOrder, PG8_ALIGN, PG8_SP2>(F.ldsl + RING_OFF, g, S, E2); GRID_BAR(); }
    }
    if (IN(10)) {
        pg8::Gemm g{F.XB(), F.Wt_gu(), M, 2 * DFF, DM}; pg8::StaticOrder S; S.init(M, 2 * DFF, F.G, (int)blockIdx.x);
        pg8::EpiSwiGLU E{F.ACT(), DFF, F.SSQ2()};
        pg8::gemm_phase<pg8::EpiSwiGLU, pg8::StaticOrder, PG8_ALIGN, PG8_SP2>(F.ldsl + RING_OFF, g, S, E);
        if (BOTH(10)) GRID_BAR();
        if ((DUPMASK >> 10) & 1) { pg8::gemm_phase<pg8::EpiSwiGLU, pg8::StaticOrder, PG8_ALIGN, PG8_SP2>(F.ldsl + RING_OFF, g, S, E); GRID_BAR(); }
    }
    if (IN(11)) {
        pg8::Gemm g{F.ACT(), F.Wt_dn(), M, DM, DFF};
        pg8::EpiResidB<false, false> E{nullptr, nullptr, F.XB(), nullptr, nullptr, (float*)(ws + WS_SLAB), F.XB()};
        if (F.G == 256) {
            pg8::TailOrder S; S.init(MP, DM, F.G, (int)blockIdx.x); S.mode = 0;
            pg8::gemm_phase<pg8::EpiResidB<false, false>, pg8::TailOrder, PG8_ALIGN, PG8_SP2>(F.ldsl + RING_OFF, g, S, E);
            if (DUP(11)) { GRID_BAR(); pg8::EpiResidB<false, false> E2{nullptr, nullptr, F.XB(), nullptr, nullptr, (float*)(ws + WS_SLAB), (bf16*)(ws + WS_ST)}; pg8::gemm_phase<pg8::EpiResidB<false, false>, pg8::TailOrder, PG8_ALIGN, PG8_SP2>(F.ldsl + RING_OFF, g, S, E2); }
        } else {
            pg8::StaticOrder S; S.init(M, DM, F.G, (int)blockIdx.x);
            pg8::gemm_phase<pg8::EpiResidB<false, false>, pg8::StaticOrder, PG8_ALIGN, PG8_SP2>(F.ldsl + RING_OFF, g, S, E);
        }
        if (BOTH(11)) GRID_BAR();
    }
    if (IN(12)) { p11_phase(F); }
#undef IN
#undef BOTH
}

extern "C" void kernel_launch(void* const* d_in, const int* in_sizes, int n_in, void* d_out, int out_size, void* d_ws, size_t ws_size, hipStream_t stream) {
    static int grid = 0;
    if (grid == 0) {
        if (n_in != 30 || in_sizes[0] != MP * DM || in_sizes[I_WIN] != DM * IN_DIM || (size_t)out_size != O_END || ws_size < WS_END) {
            fprintf(stderr, "kernel_launch: unexpected shapes: n_in %d in0 %d w_in %d out %d ws %zu; nothing launched\n", n_in, n_in > 0 ? in_sizes[0] : -1, n_in > 10 ? in_sizes[10] : -1, out_size, ws_size); grid = -1; return; }
        int dev = 0, cus = 0, per_cu = 0;
        if (hipGetDevice(&dev) != hipSuccess || hipDeviceGetAttribute(&cus, hipDeviceAttributeMultiprocessorCount, dev) != hipSuccess) { grid = -1; return; }
        if (hipFuncSetAttribute((const void*)hymba_fwd, hipFuncAttributeMaxDynamicSharedMemorySize, LDS_BYTES) != hipSuccess) { fprintf(stderr, "kernel_launch: hipFuncSetAttribute failed\n"); grid = -1; return; }
        if (hipOccupancyMaxActiveBlocksPerMultiprocessor(&per_cu, (const void*)hymba_fwd, NWAVES * 64, LDS_BYTES) != hipSuccess || per_cu < 1) { fprintf(stderr, "kernel_launch: occupancy query says %d blocks per CU\n", per_cu); per_cu = 1; }
        (void)hipGetLastError();
        grid = cus;
    }
    if (grid < 0) return;
    if (hipMemsetAsync((char*)d_ws + WS_CTL, 0, CTL_ZERO_BYTES, stream) != hipSuccess) { fprintf(stderr, "kernel_launch: memset failed\n"); return; }
    Args a{};
    for (int i = 0; i < 30; ++i) a.in[i] = (const float*)d_in[i];
    a.out = (float*)d_out; a.ws = (unsigned char*)d_ws;
    if (MK_ONE_LAUNCH) {
#ifdef PROBE_SPLIT_AT
        a.ph_lo = 0; a.ph_hi = PROBE_SPLIT_AT + 1; a.li = 0; hipLaunchKernelGGL(hymba_fwd, dim3(grid), dim3(NWAVES * 64), LDS_BYTES, stream, a);
        for (int q = 0; q < PROBE_REPS; ++q) { a.ph_lo = PROBE_SPLIT_AT; a.ph_hi = PROBE_SPLIT_AT + 1; a.li = 1; hipLaunchKernelGGL(hymba_fwd, dim3(grid), dim3(NWAVES * 64), LDS_BYTES, stream, a); }
        a.ph_lo = PROBE_SPLIT_AT + 1; a.ph_hi = NPHASE; a.li = 2; hipLaunchKernelGGL(hymba_fwd, dim3(grid), dim3(NWAVES * 64), LDS_BYTES, stream, a);
#else
        a.ph_lo = 0; a.ph_hi = NPHASE; a.li = 0;
        hipLaunchKernelGGL(hymba_fwd, dim3(grid), dim3(NWAVES * 64), LDS_BYTES, stream, a);
#endif
    } else {
        for (int p = 0; p < NPHASE; ++p) { a.ph_lo = p; a.ph_hi = p + 1; a.li = p; hipLaunchKernelGGL(hymba_fwd, dim3(grid), dim3(NWAVES * 64), LDS_BYTES, stream, a); }
    }
    const hipError_t le = hipPeekAtLastError();
    if (le != hipSuccess) fprintf(stderr, "kernel_launch: launch failed: %s\n", hipGetErrorName(le));
}
```
